# Optimizing an MI355X kernel written in HIP

```python
import math
import jax, jax.numpy as jnp
from jax import lax
import numpy as np

D_MODEL = 1024
BATCH = 8
SEQ = 4096
DEPTH = 2

DN_HEADS = 8
DN_DK = 64
DN_DV = 64
DN_CONV = 5
DN_CHUNK = 64
ATTN_HEADS = 8
ATTN_KV_HEADS = 2
ATTN_GROUP = ATTN_HEADS // ATTN_KV_HEADS
ATTN_HD = 64
WINDOW = 128
ATTN_BLOCK = 128
ATTN_SPAN = ATTN_BLOCK + 2 * WINDOW
D_FF = 4 * D_MODEL
NORM_EPS = 1e-6

DN_QK = DN_HEADS * DN_DK
DN_V = DN_HEADS * DN_DV
DN_CONV_CH = 2 * DN_QK + DN_V
ATTN_Q = ATTN_HEADS * ATTN_HD
ATTN_KV = ATTN_KV_HEADS * ATTN_HD
IN_SPLITS = (DN_QK, DN_QK, DN_V, DN_V, 4 * DN_HEADS, ATTN_Q, ATTN_KV, ATTN_KV, 2 * D_MODEL)
IN_COLS = 2 * DN_QK + 2 * DN_V + 4 * DN_HEADS + ATTN_Q + 2 * ATTN_KV + 2 * D_MODEL

kernel_name = "hybrid_gdn_swa_bidir_encoder"


def rmsnorm(t, w):
    tf = t.astype(jnp.float32)
    y = tf * lax.rsqrt(jnp.mean(tf * tf, axis=-1, keepdims=True) + NORM_EPS)
    return (y * w.astype(jnp.float32)).astype(t.dtype)


def l2norm(t):
    tf = t.astype(jnp.float32)
    return tf * lax.rsqrt(jnp.sum(tf * tf, axis=-1, keepdims=True) + NORM_EPS)


def split_cols(h, sizes):
    out, o = [], 0
    for s in sizes:
        out.append(h[..., o:o + s])
        o += s
    return out


def short_conv(u, w):
    k = w.shape[0]
    return lax.conv_general_dilated(
        u, w[:, None, :].astype(u.dtype), window_strides=(1,),
        padding=[(k // 2, k // 2)], dimension_numbers=("NWC", "WIO", "NWC"),
        feature_group_count=u.shape[-1])


def chunk_gated_delta(q, k, v, g, beta):
    b_, s_, h_, dk = q.shape
    dv = v.shape[-1]
    n = s_ // DN_CHUNK
    f32 = jnp.float32

    def chunks(t):
        return jnp.moveaxis(t.astype(f32).reshape((b_, n, DN_CHUNK) + t.shape[2:]), 2, 3)

    q = chunks(q) * (dk ** -0.5)
    k = chunks(k)
    v = chunks(v)
    g = chunks(g)
    beta = chunks(beta)
    gc = jnp.cumsum(g, axis=-1)
    idx = jnp.arange(DN_CHUNK)
    incl = idx[:, None] >= idx[None, :]
    strict = idx[:, None] > idx[None, :]
    diff = gc[..., :, None] - gc[..., None, :]
    decay = jnp.exp(jnp.where(incl, diff, -jnp.inf))
    kb = k * beta[..., None]
    lmat = jnp.where(strict, jnp.einsum("bnhik,bnhjk->bnhij", kb, k) * decay, 0.0)
    rhs = jnp.concatenate([v * beta[..., None], kb * jnp.exp(gc)[..., None]], axis=-1)
    sol = lax.linalg.triangular_solve(lmat, rhs, left_side=True, lower=True, unit_diagonal=True)
    u = sol[..., :dv]
    w = sol[..., dv:]
    attn = jnp.einsum("bnhik,bnhjk->bnhij", q, k) * decay

    def step(state, inp):
        q_i, k_i, u_i, w_i, gc_i, a_i = inp
        v_new = u_i - jnp.einsum("bhck,bhkv->bhcv", w_i, state)
        o_i = (jnp.einsum("bhck,bhkv->bhcv", q_i * jnp.exp(gc_i)[..., None], state)
               + jnp.einsum("bhij,bhjv->bhiv", a_i, v_new))
        g_last = gc_i[..., -1]
        state = (state * jnp.exp(g_last)[..., None, None]
                 + jnp.einsum("bhck,bhcv->bhkv",
                              k_i * jnp.exp(g_last[..., None] - gc_i)[..., None], v_new))
        return state, o_i

    xs = tuple(jnp.moveaxis(t, 1, 0) for t in (q, k, u, w, gc, attn))
    state0 = jnp.zeros((b_, h_, dk, dv), f32)
    _, o = lax.scan(step, state0, xs)
    o = jnp.moveaxis(jnp.moveaxis(o, 0, 1), 2, 3)
    return o.reshape(b_, s_, h_, dv)


def window_attention(q, k, v, sink):
    b_, s_, _, hd = q.shape
    nb = s_ // ATTN_BLOCK
    qb = q.reshape(b_, nb, ATTN_BLOCK, ATTN_KV_HEADS, ATTN_GROUP, hd)
    pad = ((0, 0), (WINDOW, WINDOW), (0, 0), (0, 0))
    kp = jnp.pad(k, pad)
    vp = jnp.pad(v, pad)
    kidx = (jnp.arange(nb) * ATTN_BLOCK)[:, None] + jnp.arange(ATTN_SPAN)[None, :]
    kb = kp[:, kidx]
    vb = vp[:, kidx]
    scores = jnp.einsum("bnqhgd,bnkhd->bnhgqk", qb, kb).astype(jnp.float32) * (hd ** -0.5)
    tpos = (jnp.arange(nb) * ATTN_BLOCK)[:, None] + jnp.arange(ATTN_BLOCK)[None, :]
    spos = kidx - WINDOW
    dist = jnp.abs(tpos[:, :, None] - spos[:, None, :])
    valid = (dist <= WINDOW) & (spos[:, None, :] >= 0) & (spos[:, None, :] < s_)
    slopes = jnp.exp2(-8.0 * jnp.arange(1, ATTN_HEADS + 1, dtype=jnp.float32) / ATTN_HEADS)
    slopes = slopes.reshape(ATTN_KV_HEADS, ATTN_GROUP, 1, 1)
    bias = -slopes * dist[:, None, None].astype(jnp.float32)
    scores = jnp.where(valid[:, None, None], scores + bias, -jnp.inf)
    sink_l = jnp.broadcast_to(
        sink.astype(jnp.float32).reshape(ATTN_KV_HEADS, ATTN_GROUP, 1, 1),
        scores.shape[:-1] + (1,))
    probs = jax.nn.softmax(jnp.concatenate([scores, sink_l], axis=-1), axis=-1)[..., :-1]
    out = jnp.einsum("bnhgqk,bnkhd->bnqhgd", probs.astype(v.dtype), vb)
    return out.reshape(b_, s_, ATTN_HEADS * hd)


def setup_inputs(seed: int = 0) -> dict:
    key = jax.random.key(seed)
    ks = jax.random.split(key, 20)
    f = jnp.float32

    def nrm(k, shape, scale):
        return jax.random.normal(k, shape, f) * scale

    x = nrm(ks[0], (BATCH, SEQ, D_MODEL), 1.0)
    w_in = nrm(ks[1], (DEPTH, D_MODEL, IN_COLS), D_MODEL ** -0.5)
    conv_w = nrm(ks[2], (DEPTH, DN_CONV, DN_CONV_CH), DN_CONV ** -0.5)
    a_log = jnp.log(jax.random.uniform(ks[3], (DEPTH, 2, DN_HEADS), f, 0.5, 4.0))
    dt = jnp.exp(jax.random.uniform(ks[4], (DEPTH, 2, DN_HEADS), f,
                                    math.log(1e-3), math.log(1e-1)))
    dt_bias = dt + jnp.log(-jnp.expm1(-dt))
    dn_norm_w = 1.0 + nrm(ks[5], (DEPTH, DN_DV), 0.01)
    attn_sink = nrm(ks[6], (DEPTH, ATTN_HEADS), 0.5)
    w_up_a = nrm(ks[7], (DEPTH, DN_V, D_MODEL), DN_V ** -0.5)
    w_up_b = nrm(ks[8], (DEPTH, ATTN_Q, D_MODEL), ATTN_Q ** -0.5)
    w_out = nrm(ks[9], (DEPTH, D_MODEL, D_MODEL), D_MODEL ** -0.5)
    norm_mix_pre = 1.0 + nrm(ks[10], (DEPTH, D_MODEL), 0.01)
    norm_mix_post = 1.0 + nrm(ks[11], (DEPTH, D_MODEL), 0.01)
    norm_mlp_pre = 1.0 + nrm(ks[12], (DEPTH, D_MODEL), 0.01)
    norm_mlp_post = 1.0 + nrm(ks[13], (DEPTH, D_MODEL), 0.01)
    w_mlp_in = nrm(ks[14], (DEPTH, D_MODEL, D_FF), D_MODEL ** -0.5)
    w_mlp_out = nrm(ks[15], (DEPTH, D_FF, D_MODEL), D_FF ** -0.5)
    return {"x": x, "w_in": w_in, "conv_w": conv_w, "a_log": a_log, "dt_bias": dt_bias,
            "dn_norm_w": dn_norm_w, "attn_sink": attn_sink, "w_up_a": w_up_a,
            "w_up_b": w_up_b, "w_out": w_out, "norm_mix_pre": norm_mix_pre,
            "norm_mix_post": norm_mix_post, "norm_mlp_pre": norm_mlp_pre,
            "norm_mlp_post": norm_mlp_post, "w_mlp_in": w_mlp_in, "w_mlp_out": w_mlp_out}


def reference(x, w_in, conv_w, a_log, dt_bias, dn_norm_w, attn_sink, w_up_a, w_up_b, w_out,
              norm_mix_pre, norm_mix_post, norm_mlp_pre, norm_mlp_post, w_mlp_in, w_mlp_out):
    b_, s_, _ = x.shape
    flip = lambda t: jnp.flip(t, axis=1)
    for l in range(DEPTH):
        h = rmsnorm(x, norm_mix_pre[l])
        p = h @ w_in[l]
        dq, dk_, dv_, dz, dgates, aq, ak, av, bgates = split_cols(p, IN_SPLITS)

        qkv = jax.nn.silu(short_conv(jnp.concatenate([dq, dk_, dv_], axis=-1), conv_w[l]))
        dq, dk_, dv_ = split_cols(qkv, (DN_QK, DN_QK, DN_V))
        dq = l2norm(dq.reshape(b_, s_, DN_HEADS, DN_DK))
        dk_ = l2norm(dk_.reshape(b_, s_, DN_HEADS, DN_DK))
        dv_ = dv_.reshape(b_, s_, DN_HEADS, DN_DV).astype(jnp.float32)
        a_f, a_b, be_f, be_b = split_cols(dgates.astype(jnp.float32), (DN_HEADS,) * 4)
        decay_rate = jnp.exp(a_log[l].astype(jnp.float32))
        dtb = dt_bias[l].astype(jnp.float32)
        g_f = -decay_rate[0] * jax.nn.softplus(a_f + dtb[0])
        g_b = -decay_rate[1] * jax.nn.softplus(a_b + dtb[1])
        o_fwd = chunk_gated_delta(dq, dk_, dv_, g_f, jax.nn.sigmoid(be_f))
        o_bwd = flip(chunk_gated_delta(flip(dq), flip(dk_), flip(dv_), flip(g_b),
                                       flip(jax.nn.sigmoid(be_b))))
        o_a = (o_fwd + o_bwd).astype(x.dtype)
        o_a = rmsnorm(o_a, dn_norm_w[l]) * jax.nn.silu(dz.reshape(b_, s_, DN_HEADS, DN_DV))
        y_a = o_a.reshape(b_, s_, DN_V) @ w_up_a[l]

        o_b = window_attention(aq.reshape(b_, s_, ATTN_HEADS, ATTN_HD),
                               ak.reshape(b_, s_, ATTN_KV_HEADS, ATTN_HD),
                               av.reshape(b_, s_, ATTN_KV_HEADS, ATTN_HD), attn_sink[l])
        y_b = o_b @ w_up_b[l]

        g_ma, g_mb = split_cols(bgates, (D_MODEL, D_MODEL))
        mix = (jax.nn.sigmoid(g_ma) * y_a + jax.nn.sigmoid(g_mb) * y_b) @ w_out[l]
        x = x + rmsnorm(mix, norm_mix_post[l])

        h = rmsnorm(x, norm_mlp_pre[l])
        u = jnp.square(jax.nn.relu(h @ w_mlp_in[l]))
        x = x + rmsnorm(u @ w_mlp_out[l], norm_mlp_post[l])
    return x
```

```cpp
#include <hip/hip_runtime.h>
#include <hip/hip_cooperative_groups.h>
#include <cstdio>
namespace cg = cooperative_groups;

#define DI __device__ __forceinline__
#define LAS __attribute__((address_space(3)))
typedef unsigned short bf16_t;
typedef unsigned char uchar;
typedef short bf16x8 __attribute__((ext_vector_type(8)));
typedef short bf16x4 __attribute__((ext_vector_type(4)));
typedef float f32x2 __attribute__((ext_vector_type(2)));
typedef float f32x4 __attribute__((ext_vector_type(4)));
typedef float f32x16 __attribute__((ext_vector_type(16)));
typedef unsigned u32x2 __attribute__((ext_vector_type(2)));
typedef unsigned u32x4 __attribute__((ext_vector_type(4)));
typedef __bf16 nbf2 __attribute__((ext_vector_type(2)));

constexpr int MTOK = 32768, DM = 1024, SEQ = 4096;
constexpr float EPS = 1e-6f;
constexpr size_t MiB = 1ull << 20;
constexpr size_t OFF_W = 0, W_LAYER = 30 * MiB;
constexpr size_t WO_IN = 0, WO_UP = 10 * MiB, WO_OUT = 12 * MiB, WO_W1 = 14 * MiB, WO_W2 = 22 * MiB;
constexpr size_t OFF_H = 60 * MiB;
constexpr size_t RB = 124 * MiB;
constexpr size_t OFF_A = RB, OFF_ST = RB, OFF_OB = RB + 32 * MiB, OFF_Z = RB + 96 * MiB, OFF_C = RB + 128 * MiB, OFF_E = RB + 176 * MiB,
                 OFF_GC = RB + 180 * MiB, OFF_QN = RB + 182 * MiB, OFF_KN = RB + 214 * MiB, OFF_WN = RB + 246 * MiB, OFF_KD = RB + 278 * MiB,
                 OFF_UT = RB + 310 * MiB, OFF_OA = RB + 342 * MiB, OFF_D = RB + 80 * MiB, OFF_T = RB + 208 * MiB, OFF_MIX = RB + 80 * MiB,
                 OFF_U = RB, OFF_Y = RB + 256 * MiB;
constexpr size_t WS_NEEDED = 512 * MiB;
constexpr size_t OFF_XB = RB + 320 * MiB;
constexpr size_t OFF_BAR = 508 * MiB;
constexpr unsigned LDS_ST_OFF = 136 * 1024 - 16;
constexpr size_t kDynLds = 136 * 1024;

struct Params {
  const float *x, *w_in, *conv_w, *a_log, *dt_bias, *dn_norm_w, *attn_sink, *w_up_a, *w_up_b, *w_out, *n_mix_pre, *n_mix_post, *n_mlp_pre,
      *n_mlp_post, *w_mlp_in, *w_mlp_out;
  float* out;
  uchar* ws;
};

DI float bf2f(bf16_t b) { return __uint_as_float(((unsigned)b) << 16); }
DI unsigned pk2(float lo, float hi) { f32x2 v = {lo, hi}; return __builtin_bit_cast(unsigned, __builtin_convertvector(v, nbf2)); }
DI bf16_t f2bf(float f) { return (bf16_t)(pk2(f, 0.f) & 0xffffu); }
DI bf16x8 pack8(f32x4 a, f32x4 b) { u32x4 w = {pk2(a[0], a[1]), pk2(a[2], a[3]), pk2(b[0], b[1]), pk2(b[2], b[3])}; return __builtin_bit_cast(bf16x8, w); }
DI bf16x8 cat4(bf16x4 lo, bf16x4 hi) { return __builtin_shufflevector(lo, hi, 0, 1, 2, 3, 4, 5, 6, 7); }
DI float wsum(float v) { for (int o = 32; o; o >>= 1) v += __shfl_xor(v, o); return v; }
DI float sigmoidf_(float x) { return __builtin_amdgcn_rcpf(1.0f + __expf(-x)); }
#define MFMA16(a, b, c) __builtin_amdgcn_mfma_f32_16x16x32_bf16((a), (b), (c), 0, 0, 0)
#define MFMA32(a, b, c) __builtin_amdgcn_mfma_f32_32x32x16_bf16((a), (b), (c), 0, 0, 0)

namespace pg8 {
constexpr int BM = 256, BK = 64, HALF = 128, HTB = HALF * BK * 2, NXCD = 8, WGM = 8;
DI int lds_byte(int r, int c) { const int st = (r >> 4) * 2 + (c >> 5), rr = r & 15, cc = c & 31, ob = rr * 64 + cc * 2; return st * 1024 + (ob ^ (((ob >> 9) & 1) << 5)); }
DI void stage_rc(int b, int& R, int& C) { const int st = b / 1024, sb = b % 1024, swz = sb ^ (((sb >> 9) & 1) << 5); R = (st >> 1) * 16 + swz / 64; C = (st & 1) * 32 + (swz % 64) / 2; }
DI int perm32(int rho) { const int n = rho >> 4, i = rho & 15; return 8 * (i >> 2) + 4 * n + (i & 3); }
struct Unit { int pm, pn, aux; const char* a; const char* b; };

struct SchedStd {
  const char* A; const char* Bt; int nM, nN, nwg, G, c; size_t tstep;
  DI void init(const void* A_, const void* Bt_, int M, int N, int K, int G_, int c_) { A = (const char*)A_; Bt = (const char*)Bt_; nM = M / BM; nN = N / BM; nwg = nM * nN; G = G_; c = c_; tstep = (size_t)BM * K * 2; }
  DI bool next(int i, Unit& u) const {
    const long L = (long)i * G + c; if (L >= nwg) return false;
    int wgid = (int)L; { const int q = nwg / NXCD, r = nwg % NXCD, xcd = wgid % NXCD, off = wgid / NXCD; wgid = (xcd < r ? xcd * (q + 1) : r * (q + 1) + (xcd - r) * q) + off; }
    const int nig = WGM * nN, gid = wgid / nig, fm = gid * WGM, gsz = (nM - fm) < WGM ? (nM - fm) : WGM;
    u.pm = fm + ((wgid % nig) % gsz); u.pn = (wgid % nig) / gsz; u.aux = 0; u.a = A + (size_t)u.pm * tstep; u.b = Bt + (size_t)u.pn * tstep; return true;
  }
};
struct SchedG2 {
  const char* oa; long dab; const char* wt; int G, c;
  DI bool next(int i, Unit& u) const {
    const int tile = (i >> 1) * G + c;
    const int half = i & 1; u.pm = tile >> 2; u.pn = tile & 3; u.aux = half;
    const size_t ts = (size_t)BM * 512 * 2;
    u.a = oa + (long)half * dab + (size_t)u.pm * ts; u.b = wt + (size_t)(half * 4 + u.pn) * ts; return tile < 512;
  }
};

template <class Epi, class Sched>
DI void gemm_phase(const int tid, LAS uchar* lds, const int K, const Sched& S, const Epi& E) {
  const int wid = __builtin_amdgcn_readfirstlane(tid >> 6), lane = tid & 63, wr = wid >> 2, wc = wid & 3, fr = lane & 15, fq = lane >> 4;
  const int nt = K / BK;
  unsigned voffA[2], voffB[2];
#pragma unroll
  for (int i = 0; i < 2; ++i) { int R, C; stage_rc(tid * 16 + i * 8192, R, C); const int Rb = Epi::PERM ? ((R & ~31) + perm32(R & 31)) : R;
    voffA[i] = (unsigned)(R * K + C) * 2u; voffB[i] = (unsigned)(Rb * K + C) * 2u; }
  const size_t kstep = (size_t)(BK * 2);
  const size_t hstep = (size_t)HALF * K * 2;
  const unsigned ldsw = (unsigned)wid * 1024u;
  const int aoff = lds_byte(wr * 64 + fr, fq * 8), boff = lds_byte(wc * 32 + fr, fq * 8);
#define PG8_SA(b, h) (((b) * 2 + (h)) * HTB)
#define PG8_SB(b, h) ((4 + (b) * 2 + (h)) * HTB)
#define PG8_STAGE(bufoff, gbase, voff) do { _Pragma("unroll") for (int _i = 0; _i < 2; ++_i) \
    __builtin_amdgcn_global_load_lds((const unsigned*)((const char*)(gbase) + (voff)[_i]), (LAS unsigned*)(lds + (bufoff) + ldsw + _i * 8192), 16, 0, 0); } while (0)
#define PG8_LDA(dst, b, h) do { _Pragma("unroll") for (int m = 0; m < 4; ++m) _Pragma("unroll") for (int k = 0; k < 2; ++k) dst[m][k] = *(const LAS bf16x8*)(lds + PG8_SA(b, h) + aoff + m * 2048 + k * 1024); } while (0)
#define PG8_LDB(dst, b, h) do { _Pragma("unroll") for (int n = 0; n < 2; ++n) _Pragma("unroll") for (int k = 0; k < 2; ++k) dst[n][k] = *(const LAS bf16x8*)(lds + PG8_SB(b, h) + boff + n * 2048 + k * 1024); } while (0)
#define PG8_MMA(ai, bj, At, Bt) do { __builtin_amdgcn_s_setprio(1); _Pragma("unroll") for (int m = 0; m < 4; ++m) _Pragma("unroll") for (int n = 0; n < 2; ++n) _Pragma("unroll") for (int k = 0; k < 2; ++k) \
    acc[ai][bj][m][n] = __builtin_amdgcn_mfma_f32_16x16x32_bf16(Bt[n][k], At[m][k], acc[ai][bj][m][n], 0, 0, 0); __builtin_amdgcn_s_setprio(0); } while (0)
#define PG8_WAIT_V(n) asm volatile("s_waitcnt vmcnt(" #n ")" ::: "memory")
#define PG8_WAIT_L(n) asm volatile("s_waitcnt lgkmcnt(" #n ")" ::: "memory")
#define PG8_BAR __builtin_amdgcn_s_barrier()
#define PG8_SCHED __builtin_amdgcn_sched_barrier(0)
  Unit cur, nxt; int ui = 0;
  if (!S.next(0, cur)) return;
  f32x4 acc[2][2][4][2];
#pragma unroll
  for (int a = 0; a < 2; ++a)
#pragma unroll
    for (int b = 0; b < 2; ++b)
#pragma unroll
      for (int m = 0; m < 4; ++m)
#pragma unroll
        for (int n = 0; n < 2; ++n) acc[a][b][m][n] = (f32x4){0.f, 0.f, 0.f, 0.f};
  bf16x8 At[4][2], B0[2][2], B1[2][2];
  const char* cA = cur.a; const char* cB = cur.b;
  PG8_STAGE(PG8_SB(0, 0), cB, voffB); PG8_STAGE(PG8_SA(0, 0), cA, voffA); PG8_STAGE(PG8_SB(0, 1), cB + hstep, voffB); PG8_STAGE(PG8_SA(0, 1), cA + hstep, voffA);
  if (wr == 1) PG8_BAR;
  PG8_WAIT_V(4); PG8_BAR;
  PG8_STAGE(PG8_SB(1, 0), cB + kstep, voffB); PG8_STAGE(PG8_SA(1, 0), cA + kstep, voffA); PG8_STAGE(PG8_SB(1, 1), cB + hstep + kstep, voffB);
  PG8_WAIT_V(6); PG8_BAR;
  for (;;) {
    const bool has_next = S.next(ui + 1, nxt);
    const char* nA = has_next ? nxt.a : cA; const char* nB = has_next ? nxt.b : cB;
    for (int t = 0; t < nt; t += 2) {
      const bool last = (t == nt - 2);
      const char* a1 = cA + (size_t)(t + 1) * kstep;
      const char* a2 = last ? nA : cA + (size_t)(t + 2) * kstep; const char* b2 = last ? nB : cB + (size_t)(t + 2) * kstep;
      const char* a3 = a2 + kstep; const char* b3 = b2 + kstep;
      PG8_LDB(B0, 0, 0); PG8_SCHED; PG8_LDA(At, 0, 0); PG8_STAGE(PG8_SA(1, 1), a1 + hstep, voffA);
      PG8_WAIT_L(8); PG8_BAR; PG8_WAIT_L(0); PG8_MMA(0, 0, At, B0); PG8_BAR; PG8_SCHED;
      PG8_LDB(B1, 0, 1); PG8_STAGE(PG8_SB(0, 0), b2, voffB);
      PG8_BAR; PG8_WAIT_L(0); PG8_MMA(0, 1, At, B1); PG8_BAR;
      PG8_LDA(At, 0, 1); PG8_STAGE(PG8_SA(0, 0), a2, voffA);
      PG8_BAR; PG8_WAIT_L(0); PG8_MMA(1, 0, At, B0); PG8_BAR; PG8_SCHED;
      PG8_STAGE(PG8_SB(0, 1), b2 + hstep, voffB);
      PG8_WAIT_V(6); PG8_BAR; PG8_MMA(1, 1, At, B1); PG8_BAR;
      PG8_LDB(B0, 1, 0); PG8_SCHED; PG8_LDA(At, 1, 0); PG8_STAGE(PG8_SA(0, 1), a2 + hstep, voffA);
      PG8_WAIT_L(8); PG8_BAR; PG8_WAIT_L(0); PG8_MMA(0, 0, At, B0); PG8_BAR; PG8_SCHED;
      PG8_LDB(B1, 1, 1); PG8_STAGE(PG8_SB(1, 0), b3, voffB);
      PG8_BAR; PG8_WAIT_L(0); PG8_MMA(0, 1, At, B1); PG8_BAR;
      PG8_LDA(At, 1, 1); PG8_STAGE(PG8_SA(1, 0), a3, voffA);
      PG8_BAR; PG8_WAIT_L(0); PG8_MMA(1, 0, At, B0); PG8_BAR; PG8_SCHED;
      PG8_STAGE(PG8_SB(1, 1), b3 + hstep, voffB);
      PG8_WAIT_V(6); PG8_BAR; PG8_MMA(1, 1, At, B1); PG8_BAR;
    }
    E(acc, cur, wr, wc, fr, fq);
    if (!has_next) break;
#pragma unroll
    for (int a = 0; a < 2; ++a)
#pragma unroll
      for (int b = 0; b < 2; ++b)
#pragma unroll
        for (int m = 0; m < 4; ++m)
#pragma unroll
          for (int n = 0; n < 2; ++n) acc[a][b][m][n] = (f32x4){0.f, 0.f, 0.f, 0.f};
    cur = nxt; cA = nA; cB = nB; ++ui;
  }
  PG8_WAIT_V(0);
  if (wr == 0) PG8_BAR;
  PG8_BAR;
#undef PG8_SA
#undef PG8_SB
#undef PG8_STAGE
#undef PG8_LDA
#undef PG8_LDB
#undef PG8_MMA
#undef PG8_WAIT_V
#undef PG8_WAIT_L
#undef PG8_BAR
#undef PG8_SCHED
}

struct EpiF32 {
  static constexpr bool PERM = false;
  float* C; int ldc;
  DI void operator()(const f32x4 (&acc)[2][2][4][2], const Unit& u, int wr, int wc, int fr, int fq) const {
    const int row0 = u.pm * BM + wr * 64 + fr, col0 = u.pn * BM + wc * 32 + 4 * fq;
#pragma unroll
    for (int ai = 0; ai < 2; ++ai)
#pragma unroll
      for (int m = 0; m < 4; ++m) { float* rowp = C + (size_t)(row0 + ai * HALF + m * 16) * ldc + col0;
#pragma unroll
        for (int bj = 0; bj < 2; ++bj)
#pragma unroll
          for (int n = 0; n < 2; ++n) *(f32x4*)(rowp + bj * HALF + n * 16) = acc[ai][bj][m][n]; }
  }
};
template <int ACT> struct EpiBf16 {
  static constexpr bool PERM = true;
  bf16_t* O; int ldc;
  DI void operator()(const f32x4 (&acc)[2][2][4][2], const Unit& u, int wr, int wc, int fr, int fq) const {
    const int row0 = u.pm * BM + wr * 64 + fr, col0 = u.pn * BM + wc * 32 + 8 * fq;
#pragma unroll
    for (int ai = 0; ai < 2; ++ai)
#pragma unroll
      for (int m = 0; m < 4; ++m) { bf16_t* rowp = O + (size_t)(row0 + ai * HALF + m * 16) * ldc + col0;
#pragma unroll
        for (int bj = 0; bj < 2; ++bj) { f32x4 v0 = acc[ai][bj][m][0], v1 = acc[ai][bj][m][1];
          if (ACT == 1) {
#pragma unroll
            for (int j = 0; j < 4; ++j) { float a = fmaxf(v0[j], 0.f), b = fmaxf(v1[j], 0.f); v0[j] = a * a; v1[j] = b * b; } }
          u32x4 w = {pk2(v0[0], v0[1]), pk2(v0[2], v0[3]), pk2(v1[0], v1[1]), pk2(v1[2], v1[3])};
          *(u32x4*)(rowp + bj * HALF) = w; } }
  }
};
struct EpiG1a {
  static constexpr bool PERM = true;
  bf16_t *A, *Z, *C; float* E;
  DI void operator()(const f32x4 (&acc)[2][2][4][2], const Unit& u, int wr, int wc, int fr, int fq) const {
    const int row0 = u.pm * BM + wr * 64 + fr; const int pn = u.pn;
    if (pn == 11) {
      if (wc == 0) {
#pragma unroll
        for (int ai = 0; ai < 2; ++ai)
#pragma unroll
          for (int m = 0; m < 4; ++m)
#pragma unroll
            for (int n = 0; n < 2; ++n) *(f32x4*)(E + (size_t)(row0 + ai * HALF + m * 16) * 32 + 8 * fq + 4 * n) = acc[ai][0][m][n];
      }
      return;
    }
    bf16_t* base; int ld, colt;
    if (pn < 6) { base = A; ld = 1536; colt = pn * 256; } else if (pn < 8) { base = Z; ld = 512; colt = (pn - 6) * 256; } else { base = C; ld = 768; colt = (pn - 8) * 256; }
    const int col0 = colt + wc * 32 + 8 * fq;
#pragma unroll
    for (int ai = 0; ai < 2; ++ai)
#pragma unroll
      for (int m = 0; m < 4; ++m) { bf16_t* rowp = base + (size_t)(row0 + ai * HALF + m * 16) * ld + col0;
#pragma unroll
        for (int bj = 0; bj < 2; ++bj) { const f32x4 v0 = acc[ai][bj][m][0], v1 = acc[ai][bj][m][1];
          u32x4 w = {pk2(v0[0], v0[1]), pk2(v0[2], v0[3]), pk2(v1[0], v1[1]), pk2(v1[2], v1[3])};
          *(u32x4*)(rowp + bj * HALF) = w; } }
  }
};
struct EpiG2 {
  static constexpr bool PERM = true;
  const bf16_t* D; bf16_t* T; bf16_t* Mo;
  DI void operator()(const f32x4 (&acc)[2][2][4][2], const Unit& u, int wr, int wc, int fr, int fq) const {
    const int row0 = u.pm * BM + wr * 64 + fr, col0 = u.pn * BM + wc * 32 + 8 * fq; const int half = u.aux;
#pragma unroll
    for (int ai = 0; ai < 2; ++ai) {
      u32x4 gw[4][2], tw[4][2];
#pragma unroll
      for (int m = 0; m < 4; ++m)
#pragma unroll
        for (int bj = 0; bj < 2; ++bj) { const size_t row = (size_t)(row0 + ai * HALF + m * 16); const int col = col0 + bj * HALF;
          gw[m][bj] = *(const u32x4*)(D + row * 2048 + half * 1024 + col);
          tw[m][bj] = (u32x4){0u, 0u, 0u, 0u};
          if (half) tw[m][bj] = *(const u32x4*)(T + row * 1024 + col); }
#pragma unroll
      for (int m = 0; m < 4; ++m)
#pragma unroll
        for (int bj = 0; bj < 2; ++bj) { const size_t row = (size_t)(row0 + ai * HALF + m * 16); const int col = col0 + bj * HALF;
          const u32x4 g = gw[m][bj], t = tw[m][bj];
          f32x4 v0 = acc[ai][bj][m][0], v1 = acc[ai][bj][m][1];
#pragma unroll
          for (int j = 0; j < 2; ++j) { v0[2 * j] *= sigmoidf_(__uint_as_float(g[j] << 16)); v0[2 * j + 1] *= sigmoidf_(__uint_as_float(g[j] & 0xffff0000u));
            v1[2 * j] *= sigmoidf_(__uint_as_float(g[2 + j] << 16)); v1[2 * j + 1] *= sigmoidf_(__uint_as_float(g[2 + j] & 0xffff0000u)); }
          v0[0] += __uint_as_float(t[0] << 16); v0[1] += __uint_as_float(t[0] & 0xffff0000u); v0[2] += __uint_as_float(t[1] << 16); v0[3] += __uint_as_float(t[1] & 0xffff0000u);
          v1[0] += __uint_as_float(t[2] << 16); v1[1] += __uint_as_float(t[2] & 0xffff0000u); v1[2] += __uint_as_float(t[3] << 16); v1[3] += __uint_as_float(t[3] & 0xffff0000u);
          const u32x4 w = {pk2(v0[0], v0[1]), pk2(v0[2], v0[3]), pk2(v1[0], v1[1]), pk2(v1[2], v1[3])};
          if (half == 0) *(u32x4*)(T + row * 1024 + col) = w; else *(u32x4*)(Mo + row * 1024 + col) = w; }
    }
  }
};
}

DI void rownorm_phase(const int tid, const float* xi, const bf16_t* xib, const bf16_t* y, const float* wpost, float* xo, bf16_t* xob, const float* wh, bf16_t* h) {
  const int lane = tid & 63, gw = blockIdx.x * 8 + (tid >> 6), nw = gridDim.x * 8;
  for (int row = gw; row < MTOK; row += nw) {
    f32x4 xv[4];
#pragma unroll
    for (int j = 0; j < 4; ++j) {
      if (xib) { const u32x2 xb = *(const u32x2*)(xib + (size_t)row * DM + j * 256 + lane * 4);
        xv[j] = (f32x4){__uint_as_float(xb[0] << 16), __uint_as_float(xb[0] & 0xffff0000u), __uint_as_float(xb[1] << 16), __uint_as_float(xb[1] & 0xffff0000u)}; }
      else xv[j] = *(const f32x4*)(xi + (size_t)row * DM + j * 256 + lane * 4);
    }
    if (y) {
      f32x4 yv[4]; float ss = 0.f;
#pragma unroll
      for (int j = 0; j < 4; ++j) { const u32x2 yb = *(const u32x2*)(y + (size_t)row * DM + j * 256 + lane * 4);
        yv[j] = (f32x4){__uint_as_float(yb[0] << 16), __uint_as_float(yb[0] & 0xffff0000u), __uint_as_float(yb[1] << 16), __uint_as_float(yb[1] & 0xffff0000u)}; ss += yv[j][0] * yv[j][0] + yv[j][1] * yv[j][1] + yv[j][2] * yv[j][2] + yv[j][3] * yv[j][3]; }
      const float r = rsqrtf(wsum(ss) * (1.0f / DM) + EPS);
#pragma unroll
      for (int j = 0; j < 4; ++j) { const f32x4 w = *(const f32x4*)(wpost + j * 256 + lane * 4); xv[j] += yv[j] * r * w;
        if (xob) { u32x2 o = {pk2(xv[j][0], xv[j][1]), pk2(xv[j][2], xv[j][3])}; *(u32x2*)(xob + (size_t)row * DM + j * 256 + lane * 4) = o; }
        else *(f32x4*)(xo + (size_t)row * DM + j * 256 + lane * 4) = xv[j]; }
    }
    if (wh) {
      float ss = 0.f;
#pragma unroll
      for (int j = 0; j < 4; ++j) ss += xv[j][0] * xv[j][0] + xv[j][1] * xv[j][1] + xv[j][2] * xv[j][2] + xv[j][3] * xv[j][3];
      const float r = rsqrtf(wsum(ss) * (1.0f / DM) + EPS);
#pragma unroll
      for (int j = 0; j < 4; ++j) { const f32x4 w = *(const f32x4*)(wh + j * 256 + lane * 4); const f32x4 v = xv[j] * r * w;
        u32x2 o = {pk2(v[0], v[1]), pk2(v[2], v[3])}; *(u32x2*)(h + (size_t)row * DM + j * 256 + lane * 4) = o; }
    }
  }
}

DI void wconv_phase(const int tid, const Params& p, LAS uchar* lds, const int t_begin, const int t_end, const int cidx, const int cnum) {
  LAS float* tile = (LAS float*)lds;
  constexpr int T_IN = 160 * 16, T_UP = 64 * 8, T_OUT = 32 * 16, T_W1 = 128 * 16, T_W2 = 32 * 64, T_L = T_IN + T_UP + T_OUT + T_W1 + T_W2;
  for (int t = t_begin + cidx; t < t_end; t += cnum) {
    const int l = t / T_L; int r = t % T_L;
    const float* src; int ldn, K, nsrc0, k0, r0; bf16_t* dst;
    uchar* wl = p.ws + OFF_W + (size_t)l * W_LAYER;
    if (r < T_IN) { const int rt = r / 16, kt = r % 16; r0 = rt * 32; k0 = kt * 64; K = 1024; ldn = 4896; src = p.w_in + (size_t)l * 1024 * 4896; dst = (bf16_t*)(wl + WO_IN);
      nsrc0 = r0 < 2048 ? r0 : r0 < 2816 ? r0 + 32 : r0 < 2848 ? 2048 + (r0 - 2816) : r0 < 3072 ? -1 : 2848 + (r0 - 3072); }
    else if ((r -= T_IN) < T_UP) { const int rt = r / 8, kt = r % 8; r0 = rt * 32; k0 = kt * 64; K = 512; ldn = 1024; dst = (bf16_t*)(wl + WO_UP);
      if (r0 < 1024) { src = p.w_up_a + (size_t)l * 512 * 1024; nsrc0 = r0; } else { src = p.w_up_b + (size_t)l * 512 * 1024; nsrc0 = r0 - 1024; } }
    else if ((r -= T_UP) < T_OUT) { const int rt = r / 16, kt = r % 16; r0 = rt * 32; k0 = kt * 64; K = 1024; ldn = 1024; src = p.w_out + (size_t)l * 1024 * 1024; dst = (bf16_t*)(wl + WO_OUT); nsrc0 = r0; }
    else if ((r -= T_OUT) < T_W1) { const int rt = r / 16, kt = r % 16; r0 = rt * 32; k0 = kt * 64; K = 1024; ldn = 4096; src = p.w_mlp_in + (size_t)l * 1024 * 4096; dst = (bf16_t*)(wl + WO_W1); nsrc0 = r0; }
    else { r -= T_W1; const int rt = r / 64, kt = r % 64; r0 = rt * 32; k0 = kt * 64; K = 4096; ldn = 1024; src = p.w_mlp_out + (size_t)l * 4096 * 1024; dst = (bf16_t*)(wl + WO_W2); nsrc0 = r0; }
    { const int kk = tid >> 3, n4 = (tid & 7) * 4;
      f32x4 v = {0.f, 0.f, 0.f, 0.f};
      if (nsrc0 >= 0) v = *(const f32x4*)(src + (size_t)(k0 + kk) * ldn + nsrc0 + n4);
#pragma unroll
      for (int e = 0; e < 4; ++e) tile[(n4 + e) * 65 + kk] = v[e]; }
    __syncthreads();
    { const int n = tid >> 4, k4 = (tid & 15) * 4;
      const float a = tile[n * 65 + k4], b = tile[n * 65 + k4 + 1], c = tile[n * 65 + k4 + 2], d = tile[n * 65 + k4 + 3];
      u32x2 o = {pk2(a, b), pk2(c, d)};
      *(u32x2*)(dst + (size_t)(r0 + n) * K + k0 + k4) = o; }
    __syncthreads();
  }
}

constexpr unsigned PL_KV = 0, PL_LB = 36864, PL_SM = 110592, PL_KN = 114688, PL_LSTRIDE = 16400;
template <int JB> DI void tri_inv_cols(const LAS float* Lm, const int cl, float (&X)[64]) {
#pragma unroll
  for (int i = 16 * JB; i < 64; ++i) {
    float r0 = (i - 16 * JB == cl) ? 1.0f : 0.0f, r1 = 0.f;
    const LAS float* Li = Lm;
    if (i >= 16 * JB + 3) asm volatile("" : "+v"(Li), "+v"(X[i - 3]));
#pragma unroll
    for (int j4 = 16 * JB; j4 < i; j4 += 4) { const f32x4 lv = *(const LAS f32x4*)(Li + i * 64 + j4);
      r0 -= lv[0] * X[j4]; r1 -= lv[1] * X[j4 + 1]; r0 -= lv[2] * X[j4 + 2]; r1 -= lv[3] * X[j4 + 3]; }
    X[i] = r0 + r1;
  }
}
#define RELAUNDER() int tid = tid_in; asm volatile("" : "+v"(tid)); const int lane = tid & 63, wid = __builtin_amdgcn_readfirstlane(tid >> 6); (void)lane; (void)wid
DI void tri_inv32(const LAS float* Lb, const int c, float (&X)[32]) {
#pragma unroll
  for (int i = 0; i < 32; ++i) {
    float r0 = (i == c) ? 1.0f : 0.0f, r1 = 0.f;
    const LAS float* Li = Lb;
    if (i >= 3) asm volatile("" : "+v"(Li), "+v"(X[i - 3]));
#pragma unroll
    for (int j4 = 0; j4 < i; j4 += 4) { const f32x4 lv = *(const LAS f32x4*)(Li + i * 64 + j4);
      r0 -= lv[0] * X[j4]; r1 -= lv[1] * X[j4 + 1]; r0 -= lv[2] * X[j4 + 2]; r1 -= lv[3] * X[j4 + 3]; }
    X[i] = r0 + r1;
  }
}
DI void dn_prep_item(const int tid_in, const Params& p, const int l, const int pass, const int item, LAS uchar* lds) {
  const int hp = item & 3, c = (item >> 2) & 63, bl = item >> 8, b = pass * 4 + bl;
  const size_t t0 = (size_t)b * SEQ + c * 64;
  const bf16_t* Ab = (const bf16_t*)(p.ws + OFF_A);
  const float* Eb = (const float*)(p.ws + OFF_E);
  bf16_t* QN = (bf16_t*)(p.ws + OFF_QN); bf16_t* KN = (bf16_t*)(p.ws + OFF_KN);
  bf16_t* WN = (bf16_t*)(p.ws + OFF_WN); bf16_t* KD = (bf16_t*)(p.ws + OFF_KD); bf16_t* UT = (bf16_t*)(p.ws + OFF_UT);
  float* GC = (float*)(p.ws + OFF_GC);
  LAS float* sm = (LAS float*)(lds + PL_SM);
  LAS float* gcs = sm; LAS float* bet = sm + 256; LAS float* sclw = sm + 512;
  { RELAUNDER();
    u32x4 st[7];
#pragma unroll
    for (int it = 0; it < 7; ++it) {
      const int idx = it * 512 + tid, row = idx / 48, pc = idx - row * 48, sel = pc >> 3, g8 = pc & 7, hs = sel / 3, which = sel - hs * 3;
      const int sp = c * 64 + row - 2;
      st[it] = (u32x4){0u, 0u, 0u, 0u};
      if (idx < 68 * 48 && sp >= 0 && sp < SEQ) st[it] = *(const u32x4*)(Ab + ((size_t)b * SEQ + sp) * 1536 + which * 512 + (hp * 2 + hs) * 64 + g8 * 8);
    }
#pragma unroll
    for (int it = 0; it < 7; ++it) { const int idx = it * 512 + tid, row = idx / 48, pc = idx - row * 48; if (idx < 68 * 48) *(LAS u32x4*)(lds + PL_LB + row * 784 + pc * 16) = st[it]; }
  }
  __syncthreads();
  { RELAUNDER();
  if (wid >= 6) {
#pragma unroll 1
    for (int mm = 0; mm < 2; ++mm) {
      const int mat = (wid - 6) * 2 + mm, hs = mat >> 1, dir = mat & 1, i = lane, h = hp * 2 + hs;
      const size_t tok = t0 + (dir ? 63 - i : i);
      const float a = Eb[tok * 32 + dir * 8 + h], be = Eb[tok * 32 + 16 + dir * 8 + h];
      const float xg = a + p.dt_bias[l * 16 + dir * 8 + h];
      const float sp = xg > 20.f ? xg : log1pf(__expf(xg));
      float s = -__expf(p.a_log[l * 16 + dir * 8 + h]) * sp;
#pragma unroll
      for (int o = 1; o < 64; o <<= 1) { const float t = __shfl_up(s, o); if (lane >= o) s += t; }
      const float beta = sigmoidf_(be);
      gcs[mat * 64 + i] = s; bet[mat * 64 + i] = beta; sclw[mat * 64 + i] = beta * __expf(s);
      GC[((((size_t)b * 8 + h) * 2 + dir) * 64 + (dir ? 63 - c : c)) * 64 + i] = s;
    }
  } else {
    const int g8 = tid & 7, r48 = tid >> 3, sel = r48 % 6, tg = r48 / 6, hs = sel / 3, which = sel - hs * 3, h = hp * 2 + hs;
    const int ch0 = which * 512 + h * 64 + g8 * 8;
    f32x4 w0[5], w1[5];
#pragma unroll
    for (int j = 0; j < 5; ++j) { const float* wp = p.conv_w + ((size_t)l * 5 + j) * 1536 + ch0; w0[j] = *(const f32x4*)wp; w1[j] = *(const f32x4*)(wp + 4); }
    u32x4 in[12];
#pragma unroll
    for (int r = 0; r < 12; ++r) in[r] = *(const LAS u32x4*)(lds + PL_LB + (8 * tg + r) * 784 + sel * 128 + g8 * 16);
#pragma unroll
    for (int t = 0; t < 8; ++t) {
      const int tok = 8 * tg + t;
      float acc[8];
#pragma unroll
      for (int e = 0; e < 8; ++e) acc[e] = 0.f;
#pragma unroll
      for (int j = 0; j < 5; ++j) { const u32x4 iv = in[t + j];
        acc[0] += w0[j][0] * __uint_as_float(iv[0] << 16); acc[1] += w0[j][1] * __uint_as_float(iv[0] & 0xffff0000u);
        acc[2] += w0[j][2] * __uint_as_float(iv[1] << 16); acc[3] += w0[j][3] * __uint_as_float(iv[1] & 0xffff0000u);
        acc[4] += w1[j][0] * __uint_as_float(iv[2] << 16); acc[5] += w1[j][1] * __uint_as_float(iv[2] & 0xffff0000u);
        acc[6] += w1[j][2] * __uint_as_float(iv[3] << 16); acc[7] += w1[j][3] * __uint_as_float(iv[3] & 0xffff0000u); }
      float ss = 0.f;
#pragma unroll
      for (int e = 0; e < 8; ++e) { acc[e] = acc[e] * __builtin_amdgcn_rcpf(1.0f + __expf(-acc[e])); ss += acc[e] * acc[e]; }
      if (which < 2) {
        ss += __shfl_xor(ss, 1); ss += __shfl_xor(ss, 2); ss += __shfl_xor(ss, 4);
        const float r = rsqrtf(ss + EPS) * (which == 0 ? 0.125f : 1.0f);
#pragma unroll
        for (int e = 0; e < 8; ++e) acc[e] *= r;
      }
      const u32x4 o = {pk2(acc[0], acc[1]), pk2(acc[2], acc[3]), pk2(acc[4], acc[5]), pk2(acc[6], acc[7])};
      if (which < 2) *(u32x4*)((which == 0 ? QN : KN) + (t0 + tok) * 512 + h * 64 + g8 * 8) = o;
      if (which == 1) *(LAS u32x4*)(lds + PL_KN + hs * 9216 + tok * 144 + g8 * 16) = o;
      if (which >= 1) {
        LAS bf16_t* d = (LAS bf16_t*)(lds + PL_KV + hs * 18432 + (which == 2 ? 9216 : 0)) + (g8 * 8) * 72 + tok;
#pragma unroll
        for (int e = 0; e < 4; ++e) { d[(2 * e) * 72] = (bf16_t)(o[e] & 0xffffu); d[(2 * e + 1) * 72] = (bf16_t)(o[e] >> 16); }
      }
    }
  }
  }
  __syncthreads();
  { RELAUNDER();
    const int hs = wid >> 2, tm = (wid >> 1) & 1, tn = wid & 1, h = hp * 2 + hs, r31 = lane & 31, hh = lane >> 5;
    f32x16 kk;
#pragma unroll
    for (int r = 0; r < 16; ++r) kk[r] = 0.f;
#pragma unroll
    for (int s = 0; s < 4; ++s) {
      const bf16x8 a = *(const LAS bf16x8*)(lds + PL_KN + hs * 9216 + (32 * tm + r31) * 144 + 32 * s + 16 * hh);
      const bf16x8 bb = *(const LAS bf16x8*)(lds + PL_KN + hs * 9216 + (32 * tn + r31) * 144 + 32 * s + 16 * hh);
      kk = MFMA32(a, bb, kk);
    }
    LAS float* Lf = (LAS float*)(lds + PL_LB + (hs * 2) * PL_LSTRIDE); LAS float* Lb = (LAS float*)(lds + PL_LB + (hs * 2 + 1) * PL_LSTRIDE);
    const LAS float* gcf = gcs + hs * 128; const LAS float* gcb = gcf + 64; const LAS float* bf_ = bet + hs * 128; const LAS float* bb_ = bf_ + 64;
    const int col = 32 * tn + r31;
#pragma unroll
    for (int r = 0; r < 16; ++r) {
      const int row = 32 * tm + (r & 3) + 8 * (r >> 2) + 4 * hh; const float val = kk[r];
      const int ib = 63 - row, jb = 63 - col;
      const float lf = row > col ? bf_[row] * val * __expf(gcf[row] - gcf[col]) : 0.f;
      const float lb = row < col ? bb_[ib] * val * __expf(gcb[ib] - gcb[jb]) : 0.f;
      Lf[row * 64 + col] = lf; Lb[ib * 64 + jb] = lb;
    }
  }
  __syncthreads();
  float X[32]; f32x16 t21;
#pragma unroll
  for (int i = 0; i < 32; ++i) X[i] = 0.f;
#pragma unroll
  for (int r = 0; r < 16; ++r) t21[r] = 0.f;
  { RELAUNDER();
  if (wid < 4) {
    const int mat = wid, blk = lane >> 5, c = lane & 31, hh = blk;
    const LAS float* Lm = (const LAS float*)(lds + PL_LB + mat * PL_LSTRIDE);
    tri_inv32(Lm + blk * (32 * 64 + 32), c, X);
    LAS uchar* sg = lds + PL_KN + mat * 4096;
    if (blk == 0) {
#pragma unroll
      for (int g = 0; g < 4; ++g) { u32x4 o = {pk2(X[8 * g], X[8 * g + 1]), pk2(X[8 * g + 2], X[8 * g + 3]), pk2(X[8 * g + 4], X[8 * g + 5]), pk2(X[8 * g + 6], X[8 * g + 7])}; *(LAS u32x4*)(sg + c * 64 + g * 16) = o; }
    } else {
#pragma unroll
      for (int i = 0; i < 32; ++i) *(LAS bf16_t*)(sg + 2048 + i * 64 + c * 2) = f2bf(X[i]);
    }
    asm volatile("s_waitcnt lgkmcnt(0)" ::: "memory");
    f32x16 pacc;
#pragma unroll
    for (int r = 0; r < 16; ++r) pacc[r] = 0.f;
#pragma unroll
    for (int s = 0; s < 2; ++s) {
      const LAS float* la = Lm + (32 + c) * 64 + 16 * s + 8 * hh;
      const f32x4 l0 = *(const LAS f32x4*)la, l1 = *(const LAS f32x4*)(la + 4);
      const bf16x8 af = pack8(l0, l1);
      const bf16x8 bfr = *(const LAS bf16x8*)(sg + c * 64 + (16 * s + 8 * hh) * 2);
      pacc = MFMA32(af, bfr, pacc);
    }
#pragma unroll
    for (int s = 0; s < 2; ++s) {
      u32x4 w = {pk2(pacc[8 * s], pacc[8 * s + 1]), pk2(pacc[8 * s + 2], pacc[8 * s + 3]), pk2(pacc[8 * s + 4], pacc[8 * s + 5]), pk2(pacc[8 * s + 6], pacc[8 * s + 7])};
      const bf16x8 pb = __builtin_bit_cast(bf16x8, w);
      const LAS uchar* ta = sg + 2048 + c * 64 + (16 * s + 4 * hh) * 2;
      const bf16x8 af = cat4(*(const LAS bf16x4*)ta, *(const LAS bf16x4*)(ta + 16));
      t21 = MFMA32(af, pb, t21);
    }
  } else {
    const int tt = tid - 256, mat = tt >> 6, k = tt & 63, hs = mat >> 1, dir = mat & 1, h = hp * 2 + hs;
    const LAS bf16_t* kT = (const LAS bf16_t*)(lds + PL_KV + hs * 18432) + k * 72;
    const LAS float* gcd = gcs + mat * 64; const float gl = gcd[63];
    const size_t cid = (((size_t)bl * 8 + h) * 2 + dir) * 64 + (dir ? 63 - c : c);
    bf16_t* dst = KD + cid * 4096 + k * 64;
#pragma unroll
    for (int i8 = 0; i8 < 8; ++i8) {
      const u32x4 kv = *(const LAS u32x4*)(kT + (dir ? 56 - 8 * i8 : 8 * i8));
      float v[8];
#pragma unroll
      for (int e = 0; e < 4; ++e) { v[2 * e] = __uint_as_float(kv[e] << 16); v[2 * e + 1] = __uint_as_float(kv[e] & 0xffff0000u); }
      float o[8];
#pragma unroll
      for (int e = 0; e < 8; ++e) o[e] = (dir ? v[7 - e] : v[e]) * __expf(gl - gcd[8 * i8 + e]);
      u32x4 ov = {pk2(o[0], o[1]), pk2(o[2], o[3]), pk2(o[4], o[5]), pk2(o[6], o[7])};
      *(u32x4*)(dst + 8 * i8) = ov;
    }
  }
  }
  __syncthreads();
  { RELAUNDER();
  if (wid < 4) {
    const int mat = wid, blk = lane >> 5, c = lane & 31, hh = blk, dir = mat & 1, cc = 32 * blk + c;
    LAS bf16_t* Tb = (LAS bf16_t*)(lds + PL_LB + mat * 18432);
    {
      const float su = bet[mat * 64 + cc], sw = sclw[mat * 64 + cc];
      const int tc = dir ? 63 - cc : cc;
#pragma unroll
      for (int i = 0; i < 32; ++i) { const int gi = 32 * blk + i, ti = dir ? 63 - gi : gi; Tb[ti * 72 + tc] = f2bf(X[i] * su); Tb[4608 + ti * 72 + tc] = f2bf(X[i] * sw); }
      if (blk == 1) {
#pragma unroll
        for (int i = 0; i < 32; ++i) { const int ti = dir ? 63 - i : i; Tb[ti * 72 + tc] = 0; Tb[4608 + ti * 72 + tc] = 0; }
      }
    }
    {
      const float su = bet[mat * 64 + c], sw = sclw[mat * 64 + c];
      const int tc = dir ? 63 - c : c;
#pragma unroll
      for (int r = 0; r < 16; ++r) { const int gi = 32 + (r & 3) + 8 * (r >> 2) + 4 * hh, ti = dir ? 63 - gi : gi; const float v = -t21[r];
        Tb[ti * 72 + tc] = f2bf(v * su); Tb[4608 + ti * 72 + tc] = f2bf(v * sw); }
    }
  }
  }
  __syncthreads();
  { RELAUNDER();
    const int mat = wid >> 1, which = wid & 1, hs = mat >> 1, dir = mat & 1, h = hp * 2 + hs, col = lane & 15, q = lane >> 4;
    const size_t cid = (((size_t)bl * 8 + h) * 2 + dir) * 64 + (dir ? 63 - c : c);
    const LAS bf16_t* Tm = (const LAS bf16_t*)(lds + PL_LB + mat * 18432 + which * 9216) + col * 72 + 8 * q;
    const LAS bf16_t* Xm = (const LAS bf16_t*)(lds + PL_KV + hs * 18432 + (which ? 0 : 9216)) + col * 72 + 8 * q;
    bf16x8 tf[4][2], xf[4][2];
#pragma unroll
    for (int m = 0; m < 4; ++m)
#pragma unroll
      for (int s = 0; s < 2; ++s) { tf[m][s] = *(const LAS bf16x8*)(Tm + m * 16 * 72 + 32 * s); xf[m][s] = *(const LAS bf16x8*)(Xm + m * 16 * 72 + 32 * s); }
    if (which == 0) {
      bf16_t* dst = UT + cid * 4096;
#pragma unroll
      for (int mi = 0; mi < 4; ++mi)
#pragma unroll
        for (int nd = 0; nd < 4; ++nd) {
          f32x4 acc = {0.f, 0.f, 0.f, 0.f};
          acc = MFMA16(tf[mi][0], xf[nd][0], acc); acc = MFMA16(tf[mi][1], xf[nd][1], acc);
          const int ti = 16 * mi + 4 * q;
          if (dir) { u32x2 o = {pk2(acc[3], acc[2]), pk2(acc[1], acc[0])}; *(u32x2*)(dst + (16 * nd + col) * 64 + 60 - ti) = o; }
          else { u32x2 o = {pk2(acc[0], acc[1]), pk2(acc[2], acc[3])}; *(u32x2*)(dst + (16 * nd + col) * 64 + ti) = o; }
        }
    } else {
      bf16_t* dst = WN + cid * 4096;
#pragma unroll
      for (int ni = 0; ni < 4; ++ni)
#pragma unroll
        for (int m = 0; m < 4; ++m) {
          f32x4 acc = {0.f, 0.f, 0.f, 0.f};
          acc = MFMA16(xf[m][0], tf[ni][0], acc); acc = MFMA16(xf[m][1], tf[ni][1], acc);
          const int ti = 16 * ni + col, pi = dir ? 63 - ti : ti;
          u32x2 o = {pk2(-acc[0], -acc[1]), pk2(-acc[2], -acc[3])}; *(u32x2*)(dst + pi * 64 + 16 * m + 4 * q) = o;
        }
    }
  }
  __syncthreads();
}

DI void dn_scan_block(const int tid, const Params& p, const int pass, const int grp, LAS uchar* lds) {
  const int lane = tid & 63, wid = tid >> 6, col = lane & 15, q = lane >> 4, sl = wid & 3;
  const uchar* wn = p.ws + OFF_WN + (size_t)grp * 64 * 8192 + tid * 16;
  const uchar* kd = p.ws + OFF_KD + (size_t)grp * 64 * 8192 + tid * 16;
  const uchar* utl = p.ws + OFF_UT + (size_t)grp * 64 * 8192 + tid * 16;
  bf16_t* ut = (bf16_t*)(p.ws + OFF_UT) + (size_t)grp * 64 * 4096 + (16 * sl + col) * 64 + 4 * q;
  bf16_t* st2 = (bf16_t*)(p.ws + OFF_ST) + (size_t)grp * 64 * 4096 + (16 * sl) * 64;
  bf16_t* ut2 = (bf16_t*)(p.ws + OFF_UT) + (size_t)grp * 64 * 4096 + (16 * sl) * 64;
  const float* gcp = (const float*)(p.ws + OFF_GC) + ((size_t)pass * 64 + grp) * 64 * 64 + 63;
  const unsigned ldst = (tid >> 3) * 144 + (tid & 7) * 16;
  const unsigned aoff = col * 144 + 8 * q, uoff = 18432 + (16 * sl + col) * 144 + 8 * q;
  u32x4 rq[4][3]; float gq[4];
#pragma unroll
  for (int j = 0; j < 4; ++j) { rq[j][0] = *(const u32x4*)(wn + (size_t)j * 8192); rq[j][1] = *(const u32x4*)(kd + (size_t)j * 8192); rq[j][2] = *(const u32x4*)(utl + (size_t)j * 8192); gq[j] = gcp[j * 64]; }
  f32x4 S[4];
#pragma unroll
  for (int m = 0; m < 4; ++m) S[m] = (f32x4){0.f, 0.f, 0.f, 0.f};
#pragma unroll 1
  for (int n0 = 0; n0 < 64; n0 += 4) {
#pragma unroll
    for (int j = 0; j < 4; ++j) {
      const int n = n0 + j;
      LAS uchar* base = lds + (j & 1) * 27648;
      *(LAS u32x4*)(base + ldst) = rq[j][0]; *(LAS u32x4*)(base + 9216 + ldst) = rq[j][1]; *(LAS u32x4*)(base + 18432 + ldst) = rq[j][2];
      const float gl = gq[j];
      if (n0 + 4 < 64) { rq[j][0] = *(const u32x4*)(wn + (size_t)(n + 4) * 8192); rq[j][1] = *(const u32x4*)(kd + (size_t)(n + 4) * 8192); rq[j][2] = *(const u32x4*)(utl + (size_t)(n + 4) * 8192); gq[j] = gcp[(n + 4) * 64]; }
      __syncthreads();
      if (wid < 4) {
        const float e = __expf(gl);
        bf16x8 Sb[2];
#pragma unroll
        for (int s = 0; s < 2; ++s) Sb[s] = pack8(S[2 * s], S[2 * s + 1]);
        f32x4 vn[4];
#pragma unroll
        for (int m = 0; m < 4; ++m) {
          const bf16x4 ub = *(const LAS bf16x4*)(base + uoff + 32 * m);
          vn[m] = (f32x4){bf2f((bf16_t)ub[0]), bf2f((bf16_t)ub[1]), bf2f((bf16_t)ub[2]), bf2f((bf16_t)ub[3])};
#pragma unroll
          for (int s = 0; s < 2; ++s) { const LAS uchar* pa = base + aoff + m * 2304 + 64 * s;
            vn[m] = MFMA16(cat4(*(const LAS bf16x4*)pa, *(const LAS bf16x4*)(pa + 32)), Sb[s], vn[m]); }
        }
        bf16x8 Vb[2];
#pragma unroll
        for (int s = 0; s < 2; ++s) Vb[s] = pack8(vn[2 * s], vn[2 * s + 1]);
        {
          LAS uchar* my = lds + 55296 + wid * 4608;
#pragma unroll
          for (int m = 0; m < 4; ++m) { const u32x4 sw = __builtin_bit_cast(u32x4, Sb[m >> 1]), vw = __builtin_bit_cast(u32x4, Vb[m >> 1]);
            u32x2 so = {sw[2 * (m & 1)], sw[2 * (m & 1) + 1]}, vo = {vw[2 * (m & 1)], vw[2 * (m & 1) + 1]};
            *(LAS u32x2*)(my + col * 144 + (16 * m + 4 * q) * 2) = so; *(LAS u32x2*)(my + 2304 + col * 144 + (16 * m + 4 * q) * 2) = vo; }
          asm volatile("s_waitcnt lgkmcnt(0)" ::: "memory");
          const int rr = lane >> 2, sg = lane & 3;
          const u32x4 a0 = *(const LAS u32x4*)(my + rr * 144 + sg * 32), a1 = *(const LAS u32x4*)(my + rr * 144 + sg * 32 + 16);
          const u32x4 b0 = *(const LAS u32x4*)(my + 2304 + rr * 144 + sg * 32), b1 = *(const LAS u32x4*)(my + 2304 + rr * 144 + sg * 32 + 16);
          bf16_t* sdst = st2 + (size_t)n * 4096 + rr * 64 + sg * 16; bf16_t* vdst = ut2 + (size_t)n * 4096 + rr * 64 + sg * 16;
          *(u32x4*)sdst = a0; *(u32x4*)(sdst + 8) = a1; *(u32x4*)vdst = b0; *(u32x4*)(vdst + 8) = b1;
          asm volatile("" ::: "memory");
        }
#pragma unroll
        for (int m = 0; m < 4; ++m) { S[m] *= e;
#pragma unroll
          for (int s = 0; s < 2; ++s) { const LAS uchar* pa = base + 9216 + aoff + m * 2304 + 64 * s;
            S[m] = MFMA16(cat4(*(const LAS bf16x4*)pa, *(const LAS bf16x4*)(pa + 32)), Vb[s], S[m]); } }
      }
    }
  }
}

DI void dn_out_item(const int tid, const Params& p, const int l, const int pass, const int item, LAS uchar* lds) {
  const int lane = tid & 63, wid = tid >> 6, col = lane & 15, q = lane >> 4;
  const int h = item & 7, c = (item >> 3) & 63, bl = item >> 9, b = pass * 4 + bl;
  const size_t t0 = (size_t)b * SEQ + c * 64;
  const bf16_t* QN = (const bf16_t*)(p.ws + OFF_QN); const bf16_t* KN = (const bf16_t*)(p.ws + OFF_KN);
  const bf16_t* ST = (const bf16_t*)(p.ws + OFF_ST); const bf16_t* VN = (const bf16_t*)(p.ws + OFF_UT);
  const float* GC = (const float*)(p.ws + OFF_GC);
  LAS float* osum = (LAS float*)lds;
  {
    const int dir = wid >> 2, ig = wid & 3, nproc = dir ? 63 - c : c;
    const size_t cidp = (((size_t)bl * 8 + h) * 2 + dir) * 64 + nproc, cidg = (((size_t)b * 8 + h) * 2 + dir) * 64 + nproc;
    const int i = 16 * ig + col; const size_t toki = t0 + (dir ? 63 - i : i);
    bf16x8 qb[2];
#pragma unroll
    for (int s = 0; s < 2; ++s) qb[s] = *(const bf16x8*)(QN + toki * 512 + h * 64 + 32 * s + 8 * q);
    const float gci = GC[cidg * 64 + i];
    f32x4 at[4];
#pragma unroll
    for (int m = 0; m < 4; ++m) {
      at[m] = (f32x4){0.f, 0.f, 0.f, 0.f};
      if (m <= ig) {
        const int jr = 16 * m + col; const size_t tokj = t0 + (dir ? 63 - jr : jr);
#pragma unroll
        for (int s = 0; s < 2; ++s) { const bf16x8 kf = *(const bf16x8*)(KN + tokj * 512 + h * 64 + 32 * s + 8 * q); at[m] = MFMA16(kf, qb[s], at[m]); }
        const f32x4 gcj = *(const f32x4*)(GC + cidg * 64 + 16 * m + 4 * q);
#pragma unroll
        for (int r = 0; r < 4; ++r) { const int j = 16 * m + 4 * q + r; at[m][r] = (i >= j) ? at[m][r] * __expf(gci - gcj[r]) : 0.f; }
      }
    }
    bf16x8 pb[2];
#pragma unroll
    for (int s = 0; s < 2; ++s) pb[s] = pack8(at[2 * s], at[2 * s + 1]);
    const float eg = __expf(gci);
    const int tokrow = dir ? 63 - i : i;
#pragma unroll
    for (int mv = 0; mv < 4; ++mv) {
      f32x4 acc = {0.f, 0.f, 0.f, 0.f};
#pragma unroll
      for (int s = 0; s < 2; ++s) { const bf16x8 sa = *(const bf16x8*)(ST + cidp * 4096 + (16 * mv + col) * 64 + 32 * s + 8 * q); acc = MFMA16(sa, qb[s], acc); }
      acc *= eg;
#pragma unroll
      for (int s = 0; s < 2; ++s) { const bf16_t* pv = VN + cidp * 4096 + (16 * mv + col) * 64 + 32 * s + 4 * q;
        acc = MFMA16(cat4(*(const bf16x4*)pv, *(const bf16x4*)(pv + 16)), pb[s], acc); }
      *(LAS f32x4*)(osum + (dir * 64 + tokrow) * 68 + 16 * mv + 4 * q) = acc;
    }
  }
  __syncthreads();
  {
    const int tok = tid >> 3, vg = tid & 7;
    const LAS float* o0 = osum + tok * 68 + vg * 8; const LAS float* o1 = o0 + 64 * 68;
    float o[8]; float ss = 0.f;
#pragma unroll
    for (int e = 0; e < 8; ++e) { o[e] = o0[e] + o1[e]; ss += o[e] * o[e]; }
    ss += __shfl_xor(ss, 1); ss += __shfl_xor(ss, 2); ss += __shfl_xor(ss, 4);
    const float r = rsqrtf(ss * (1.0f / 64.0f) + EPS);
    const u32x4 zv = *(const u32x4*)((const bf16_t*)(p.ws + OFF_Z) + (t0 + tok) * 512 + h * 64 + vg * 8);
    const float* nw = p.dn_norm_w + l * 64 + vg * 8;
    float res[8];
#pragma unroll
    for (int e = 0; e < 4; ++e) { const float zl = __uint_as_float(zv[e] << 16), zh = __uint_as_float(zv[e] & 0xffff0000u);
      res[2 * e] = o[2 * e] * r * nw[2 * e] * (zl * __builtin_amdgcn_rcpf(1.0f + __expf(-zl))); res[2 * e + 1] = o[2 * e + 1] * r * nw[2 * e + 1] * (zh * __builtin_amdgcn_rcpf(1.0f + __expf(-zh))); }
    u32x4 ov = {pk2(res[0], res[1]), pk2(res[2], res[3]), pk2(res[4], res[5]), pk2(res[6], res[7])};
    *(u32x4*)((bf16_t*)(p.ws + OFF_OA) + (t0 + tok) * 512 + h * 64 + vg * 8) = ov;
  }
  __syncthreads();
}

DI void dn_out_wave(const int tid, const Params& p, const int l, const int pass, const int item) {
  const int lane = tid & 63, col = lane & 15, q = lane >> 4;
  const int h = item & 7, c = (item >> 3) & 63, bl = item >> 9, b = pass * 4 + bl;
  const size_t t0 = (size_t)b * SEQ + c * 64;
  const bf16_t* QN = (const bf16_t*)(p.ws + OFF_QN); const bf16_t* KN = (const bf16_t*)(p.ws + OFF_KN);
  const bf16_t* ST = (const bf16_t*)(p.ws + OFF_ST); const bf16_t* VN = (const bf16_t*)(p.ws + OFF_UT);
  const float* GC = (const float*)(p.ws + OFF_GC);
  const bf16_t* Zb = (const bf16_t*)(p.ws + OFF_Z); bf16_t* OA = (bf16_t*)(p.ws + OFF_OA);
#pragma unroll 1
  for (int ig = 0; ig < 4; ++ig) {
    const int tl = 16 * ig + col; const size_t tokq = t0 + tl;
    bf16x8 qb[2];
#pragma unroll
    for (int s = 0; s < 2; ++s) qb[s] = *(const bf16x8*)(QN + tokq * 512 + h * 64 + 32 * s + 8 * q);
    f32x4 o[4];
#pragma unroll
    for (int mv = 0; mv < 4; ++mv) o[mv] = (f32x4){0.f, 0.f, 0.f, 0.f};
#pragma unroll
    for (int dir = 0; dir < 2; ++dir) {
      const int nproc = dir ? 63 - c : c, i = dir ? 63 - tl : tl, igd = dir ? 3 - ig : ig;
      const size_t cidp = (((size_t)bl * 8 + h) * 2 + dir) * 64 + nproc, cidg = (((size_t)b * 8 + h) * 2 + dir) * 64 + nproc;
      const float gci = GC[cidg * 64 + i];
      f32x4 at[4];
#pragma unroll
      for (int m = 0; m < 4; ++m) {
        at[m] = (f32x4){0.f, 0.f, 0.f, 0.f};
        if (m <= igd) {
          const int jr = 16 * m + col; const size_t tokj = t0 + (dir ? 63 - jr : jr);
#pragma unroll
          for (int s = 0; s < 2; ++s) { const bf16x8 kf = *(const bf16x8*)(KN + tokj * 512 + h * 64 + 32 * s + 8 * q); at[m] = MFMA16(kf, qb[s], at[m]); }
          const f32x4 gcj = *(const f32x4*)(GC + cidg * 64 + 16 * m + 4 * q);
#pragma unroll
          for (int r = 0; r < 4; ++r) { const int j = 16 * m + 4 * q + r; at[m][r] = (i >= j) ? at[m][r] * __expf(gci - gcj[r]) : 0.f; }
        }
      }
      bf16x8 pb[2];
#pragma unroll
      for (int s = 0; s < 2; ++s) pb[s] = pack8(at[2 * s], at[2 * s + 1]);
      const float eg = __expf(gci);
#pragma unroll
      for (int mv = 0; mv < 4; ++mv) {
        f32x4 acc = {0.f, 0.f, 0.f, 0.f};
#pragma unroll
        for (int s = 0; s < 2; ++s) { const bf16x8 sa = *(const bf16x8*)(ST + cidp * 4096 + (16 * mv + col) * 64 + 32 * s + 8 * q); acc = MFMA16(sa, qb[s], acc); }
        acc *= eg;
#pragma unroll
        for (int s = 0; s < 2; ++s) { const bf16_t* pv = VN + cidp * 4096 + (16 * mv + col) * 64 + 32 * s + 4 * q;
          acc = MFMA16(cat4(*(const bf16x4*)pv, *(const bf16x4*)(pv + 16)), pb[s], acc); }
        o[mv] += acc;
      }
    }
    float ss = 0.f;
#pragma unroll
    for (int mv = 0; mv < 4; ++mv) ss += o[mv][0] * o[mv][0] + o[mv][1] * o[mv][1] + o[mv][2] * o[mv][2] + o[mv][3] * o[mv][3];
    ss += __shfl_xor(ss, 16); ss += __shfl_xor(ss, 32);
    const float rn = rsqrtf(ss * (1.0f / 64.0f) + EPS);
#pragma unroll
    for (int mv = 0; mv < 4; ++mv) {
      const int v0 = 16 * mv + 4 * q;
      const u32x2 zv = *(const u32x2*)(Zb + tokq * 512 + h * 64 + v0);
      const f32x4 nw = *(const f32x4*)(p.dn_norm_w + l * 64 + v0);
      const float z0 = __uint_as_float(zv[0] << 16), z1 = __uint_as_float(zv[0] & 0xffff0000u), z2 = __uint_as_float(zv[1] << 16), z3 = __uint_as_float(zv[1] & 0xffff0000u);
      const float r0 = o[mv][0] * rn * nw[0] * (z0 * __builtin_amdgcn_rcpf(1.0f + __expf(-z0))), r1 = o[mv][1] * rn * nw[1] * (z1 * __builtin_amdgcn_rcpf(1.0f + __expf(-z1)));
      const float r2 = o[mv][2] * rn * nw[2] * (z2 * __builtin_amdgcn_rcpf(1.0f + __expf(-z2))), r3 = o[mv][3] * rn * nw[3] * (z3 * __builtin_amdgcn_rcpf(1.0f + __expf(-z3)));
      u32x2 ov = {pk2(r0, r1), pk2(r2, r3)};
      *(u32x2*)(OA + tokq * 512 + h * 64 + v0) = ov;
    }
  }
}

constexpr unsigned OS_BUF = 65024, OS_SS = 2 * OS_BUF;
DI void dn_out_phase(const int tid, const Params& p, const int l, const int pass, LAS uchar* lds) {
  const int lane = tid & 63, wid = __builtin_amdgcn_readfirstlane(tid >> 6), col = lane & 15, q = lane >> 4, ig = wid & 3, vh = wid >> 2;
  const bf16_t* QN = (const bf16_t*)(p.ws + OFF_QN); const bf16_t* KN = (const bf16_t*)(p.ws + OFF_KN);
  const bf16_t* ST = (const bf16_t*)(p.ws + OFF_ST); const bf16_t* VN = (const bf16_t*)(p.ws + OFF_UT);
  const float* GC = (const float*)(p.ws + OFF_GC);
  const bf16_t* Zb = (const bf16_t*)(p.ws + OFF_Z); bf16_t* OA = (bf16_t*)(p.ws + OFF_OA);
  const int G = gridDim.x, row = tid >> 3, c8 = tid & 7;
  const unsigned ldst = row * 144 + c8 * 16;
  u32x4 stg[7]; u32x4 gst = {0u, 0u, 0u, 0u};
#define OUT_ISSUE(item) do { const int h_ = (item) & 7, c_ = ((item) >> 3) & 63, bl_ = (item) >> 9, b_ = pass * 4 + bl_; \
    const size_t t0_ = (size_t)b_ * SEQ + c_ * 64, gf_ = (((size_t)bl_ * 8 + h_) * 2) * 64 + c_, gb_ = (((size_t)bl_ * 8 + h_) * 2 + 1) * 64 + (63 - c_); \
    stg[0] = *(const u32x4*)(QN + (t0_ + row) * 512 + h_ * 64 + c8 * 8); stg[1] = *(const u32x4*)(KN + (t0_ + row) * 512 + h_ * 64 + c8 * 8); \
    stg[2] = *(const u32x4*)(ST + gf_ * 4096 + row * 64 + c8 * 8); stg[3] = *(const u32x4*)(ST + gb_ * 4096 + row * 64 + c8 * 8); \
    stg[4] = *(const u32x4*)(VN + gf_ * 4096 + row * 64 + c8 * 8); stg[5] = *(const u32x4*)(VN + gb_ * 4096 + row * 64 + c8 * 8); \
    stg[6] = *(const u32x4*)(Zb + (t0_ + row) * 512 + h_ * 64 + c8 * 8); \
    if (tid < 32) { const size_t gg_ = (tid < 16) ? ((((size_t)b_ * 8 + h_) * 2) * 64 + c_) : ((((size_t)b_ * 8 + h_) * 2 + 1) * 64 + (63 - c_)); gst = *(const u32x4*)(GC + gg_ * 64 + (tid & 15) * 4); } } while (0)
#define OUT_STORE(buf) do { LAS uchar* b__ = lds + (buf) * OS_BUF; _Pragma("unroll") for (int a = 0; a < 7; ++a) *(LAS u32x4*)(b__ + a * 9216 + ldst) = stg[a]; \
    if (tid < 32) *(LAS u32x4*)(b__ + 64512 + tid * 16) = gst; } while (0)
  int item = blockIdx.x, cur = 0;
  if (item < 2048) { OUT_ISSUE(item); OUT_STORE(0); }
  __syncthreads();
  for (; item < 2048; item += G, cur ^= 1) {
    const int nxt = item + G;
    if (nxt < 2048) OUT_ISSUE(nxt);
    const int h = item & 7, c = (item >> 3) & 63, bl = item >> 9, b = pass * 4 + bl;
    const size_t t0 = (size_t)b * SEQ + c * 64;
    const LAS uchar* B = lds + cur * OS_BUF;
    const int tl = 16 * ig + col;
    bf16x8 qb[2];
#pragma unroll
    for (int s = 0; s < 2; ++s) qb[s] = *(const LAS bf16x8*)(B + tl * 144 + 64 * s + 16 * q);
    f32x4 o[2];
    o[0] = (f32x4){0.f, 0.f, 0.f, 0.f}; o[1] = o[0];
#pragma unroll
    for (int dir = 0; dir < 2; ++dir) {
      const int i = dir ? 63 - tl : tl, igd = dir ? 3 - ig : ig;
      const LAS float* gcd = (const LAS float*)(B + 64512) + dir * 64;
      const float gci = gcd[i];
      f32x4 at[4];
#pragma unroll
      for (int m = 0; m < 4; ++m) {
        at[m] = (f32x4){0.f, 0.f, 0.f, 0.f};
        if (m <= igd) {
          const int jr = 16 * m + col, trow = dir ? 63 - jr : jr;
#pragma unroll
          for (int s = 0; s < 2; ++s) { const bf16x8 kf = *(const LAS bf16x8*)(B + 9216 + trow * 144 + 64 * s + 16 * q); at[m] = MFMA16(kf, qb[s], at[m]); }
          const f32x4 gcj = *(const LAS f32x4*)(gcd + 16 * m + 4 * q);
#pragma unroll
          for (int r = 0; r < 4; ++r) { const int j = 16 * m + 4 * q + r; at[m][r] = (i >= j) ? at[m][r] * __expf(gci - gcj[r]) : 0.f; }
        }
      }
      bf16x8 pb[2];
#pragma unroll
      for (int s = 0; s < 2; ++s) pb[s] = pack8(at[2 * s], at[2 * s + 1]);
      const float eg = __expf(gci);
      const LAS uchar* Sd = B + (2 + dir) * 9216; const LAS uchar* Vd = B + (4 + dir) * 9216;
#pragma unroll
      for (int mvi = 0; mvi < 2; ++mvi) {
        const int vr = 16 * (2 * vh + mvi) + col;
        f32x4 acc = {0.f, 0.f, 0.f, 0.f};
#pragma unroll
        for (int s = 0; s < 2; ++s) { const bf16x8 sa = *(const LAS bf16x8*)(Sd + vr * 144 + 64 * s + 16 * q); acc = MFMA16(sa, qb[s], acc); }
        acc *= eg;
#pragma unroll
        for (int s = 0; s < 2; ++s) { const LAS uchar* pv = Vd + vr * 144 + 64 * s + 8 * q;
          acc = MFMA16(cat4(*(const LAS bf16x4*)pv, *(const LAS bf16x4*)(pv + 32)), pb[s], acc); }
        o[mvi] += acc;
      }
    }
    float ss = 0.f;
#pragma unroll
    for (int mvi = 0; mvi < 2; ++mvi) ss += o[mvi][0] * o[mvi][0] + o[mvi][1] * o[mvi][1] + o[mvi][2] * o[mvi][2] + o[mvi][3] * o[mvi][3];
    ss += __shfl_xor(ss, 16); ss += __shfl_xor(ss, 32);
    LAS float* ssum = (LAS float*)(lds + OS_SS);
    if (q == 0) ssum[vh * 64 + tl] = ss;
    __syncthreads();
    const float rn = rsqrtf((ssum[tl] + ssum[64 + tl]) * (1.0f / 64.0f) + EPS);
#pragma unroll
    for (int mvi = 0; mvi < 2; ++mvi) {
      const int v0 = 16 * (2 * vh + mvi) + 4 * q;
      const u32x2 zv = *(const LAS u32x2*)(B + 6 * 9216 + tl * 144 + v0 * 2);
      const f32x4 nw = *(const f32x4*)(p.dn_norm_w + l * 64 + v0);
      const float z0 = __uint_as_float(zv[0] << 16), z1 = __uint_as_float(zv[0] & 0xffff0000u), z2 = __uint_as_float(zv[1] << 16), z3 = __uint_as_float(zv[1] & 0xffff0000u);
      const float r0 = o[mvi][0] * rn * nw[0] * (z0 * __builtin_amdgcn_rcpf(1.0f + __expf(-z0))), r1 = o[mvi][1] * rn * nw[1] * (z1 * __builtin_amdgcn_rcpf(1.0f + __expf(-z1)));
      const float r2 = o[mvi][2] * rn * nw[2] * (z2 * __builtin_amdgcn_rcpf(1.0f + __expf(-z2))), r3 = o[mvi][3] * rn * nw[3] * (z3 * __builtin_amdgcn_rcpf(1.0f + __expf(-z3)));
      u32x2 ov = {pk2(r0, r1), pk2(r2, r3)};
      *(u32x2*)(OA + (t0 + tl) * 512 + h * 64 + v0) = ov;
    }
    if (nxt < 2048) OUT_STORE(cur ^ 1);
    __syncthreads();
  }
#undef OUT_ISSUE
#undef OUT_STORE
}

DI void attn_item(const int tid, const Params& p, const int l, const int item, LAS uchar* lds) {
  const int lane = tid & 63, wid = tid >> 6, col = lane & 31, hh = lane >> 5;
  const int qblk = item & 31, kvh = (item >> 5) & 1, b = item >> 6;
  const int t0 = qblk * 128; const size_t rowbase = (size_t)b * SEQ;
  const bf16_t* Cb = (const bf16_t*)(p.ws + OFF_C);
  bf16_t* OB = (bf16_t*)(p.ws + OFF_OB);
  LAS bf16_t* Ks = (LAS bf16_t*)lds; LAS bf16_t* VT = (LAS bf16_t*)(lds + 384 * 72 * 2);
#pragma unroll 1
  for (int it = 0; it < 6; ++it) {
    const int idx = it * 512 + tid, r = idx >> 3, pc = idx & 7, s = t0 - 128 + r;
    u32x4 kv = {0u, 0u, 0u, 0u}, vv = {0u, 0u, 0u, 0u};
    if (s >= 0 && s < SEQ) { const bf16_t* src = Cb + (rowbase + s) * 768 + 512 + kvh * 64 + pc * 8; kv = *(const u32x4*)src; vv = *(const u32x4*)(src + 128); }
    *(LAS u32x4*)(Ks + r * 72 + pc * 8) = kv;
#pragma unroll
    for (int e = 0; e < 4; ++e) { VT[(pc * 8 + 2 * e) * 392 + r] = (bf16_t)(vv[e] & 0xffffu); VT[(pc * 8 + 2 * e + 1) * 392 + r] = (bf16_t)(vv[e] >> 16); }
  }
  __syncthreads();
  {
    const int g = wid >> 1, qh = wid & 1, hq = kvh * 4 + g;
    const float slope = exp2f(-(float)(hq + 1)), sink = p.attn_sink[l * 8 + hq];
#pragma unroll 1
    for (int qg = 0; qg < 2; ++qg) {
      const int q0 = 64 * qh + 32 * qg; const size_t tokq = rowbase + t0 + q0 + col;
      bf16x8 qf[4];
#pragma unroll
      for (int s = 0; s < 4; ++s) qf[s] = *(const bf16x8*)(Cb + tokq * 768 + hq * 64 + 16 * s + 8 * hh);
      float m_run = sink, l_run = 1.0f;
      f32x16 o0, o1;
#pragma unroll
      for (int r = 0; r < 16; ++r) { o0[r] = 0.f; o1[r] = 0.f; }
      const int kt0 = q0 >> 5;
#pragma unroll 1
      for (int kt = kt0; kt < kt0 + 9; ++kt) {
        f32x16 sc;
#pragma unroll
        for (int r = 0; r < 16; ++r) sc[r] = 0.f;
#pragma unroll
        for (int s = 0; s < 4; ++s) { const bf16x8 kf = *(const LAS bf16x8*)(Ks + (32 * kt + col) * 72 + 16 * s + 8 * hh); sc = MFMA32(kf, qf[s], sc); }
        float tmax = -INFINITY;
#pragma unroll
        for (int r = 0; r < 16; ++r) {
          const int kl = 32 * kt + (r & 3) + 8 * (r >> 2) + 4 * hh, sg = t0 - 128 + kl, d = q0 + col + 128 - kl, ad = d < 0 ? -d : d;
          const bool valid = (ad <= 128) && (sg >= 0) && (sg < SEQ);
          sc[r] = valid ? sc[r] * 0.125f - slope * (float)ad : -INFINITY;
          tmax = fmaxf(tmax, sc[r]);
        }
        tmax = fmaxf(tmax, __shfl_xor(tmax, 32));
        const float mn = fmaxf(m_run, tmax), alpha = __expf(m_run - mn);
        float psum = 0.f;
#pragma unroll
        for (int r = 0; r < 16; ++r) { sc[r] = __expf(sc[r] - mn); psum += sc[r]; }
        psum += __shfl_xor(psum, 32);
        l_run = l_run * alpha + psum; m_run = mn;
#pragma unroll
        for (int r = 0; r < 16; ++r) { o0[r] *= alpha; o1[r] *= alpha; }
        bf16x8 pf[2];
#pragma unroll
        for (int s = 0; s < 2; ++s) { u32x4 w = {pk2(sc[8 * s], sc[8 * s + 1]), pk2(sc[8 * s + 2], sc[8 * s + 3]), pk2(sc[8 * s + 4], sc[8 * s + 5]), pk2(sc[8 * s + 6], sc[8 * s + 7])}; pf[s] = __builtin_bit_cast(bf16x8, w); }
#pragma unroll
        for (int s = 0; s < 2; ++s) {
          const LAS bf16_t* v0 = VT + col * 392 + 32 * kt + 16 * s + 4 * hh; const LAS bf16_t* v1 = v0 + 32 * 392;
          o0 = MFMA32(cat4(*(const LAS bf16x4*)v0, *(const LAS bf16x4*)(v0 + 8)), pf[s], o0);
          o1 = MFMA32(cat4(*(const LAS bf16x4*)v1, *(const LAS bf16x4*)(v1 + 8)), pf[s], o1);
        }
      }
      const float inv = 1.0f / l_run;
      bf16_t* dst = OB + tokq * 512 + hq * 64 + 4 * hh;
#pragma unroll
      for (int rg = 0; rg < 4; ++rg) {
        u32x2 a = {pk2(o0[4 * rg] * inv, o0[4 * rg + 1] * inv), pk2(o0[4 * rg + 2] * inv, o0[4 * rg + 3] * inv)};
        u32x2 c2 = {pk2(o1[4 * rg] * inv, o1[4 * rg + 1] * inv), pk2(o1[4 * rg + 2] * inv, o1[4 * rg + 3] * inv)};
        *(u32x2*)(dst + 8 * rg) = a; *(u32x2*)(dst + 32 + 8 * rg) = c2;
      }
    }
  }
  __syncthreads();
}


#define XB_TMO      128
#define XB_XCNT(j)  (256  + 64 * (j))
#define XB_XSUB(j)  (1280 + 64 * (j))
#define XB_XGEN(j)  (2304 + 64 * (j))
#define XB_TOP      3328
#define XB_TOPGEN   3392
#define XCD_BAR_WORDS 3456
#define XB_SPIN_CAP (1u << 18)
DI unsigned xb_ld(unsigned* p)              { return __hip_atomic_load(p, __ATOMIC_RELAXED, __HIP_MEMORY_SCOPE_AGENT); }
DI unsigned xb_add(unsigned* p, unsigned v) { return __hip_atomic_fetch_add(p, v, __ATOMIC_RELAXED, __HIP_MEMORY_SCOPE_AGENT); }
DI unsigned xb_xcc_id() { return (unsigned)__builtin_amdgcn_s_getreg((3 << 11) | 20) & 0xFu; }
#define XB_SPIN(cond, bar) do { unsigned _sp = 0; while (cond) { __builtin_amdgcn_s_sleep(1); \
    if ((++_sp & 255u) == 0u) { if (xb_ld(&(bar)[XB_TMO])) break; if (_sp > XB_SPIN_CAP) { atomicAdd(&(bar)[XB_TMO], 1u); break; } } } } while (0)
struct XcdBarrier { unsigned* bar; unsigned x; volatile LAS unsigned* st; };
DI XcdBarrier xcd_barrier_post(unsigned* bar, volatile LAS unsigned* st) {
  XcdBarrier b; b.bar = bar; b.x = xb_xcc_id(); b.st = st;
  if (threadIdx.x == 0) (void)xb_add(&bar[XB_XCNT(b.x)], 1u);
  return b;
}
DI void xcd_barrier_complete(unsigned* bar, unsigned x, unsigned& nloc, unsigned& nx) {
  const unsigned G = gridDim.x * gridDim.y * gridDim.z;
  unsigned sum, cnt, mine, sp = 0u;
  for (;;) {
    sum = 0u; cnt = 0u; mine = 0u;
#pragma unroll
    for (unsigned j = 0; j < 16; ++j) { const unsigned c = xb_ld(&bar[XB_XCNT(j)]); sum += c; cnt += (c > 0u) ? 1u : 0u; mine = (j == x) ? c : mine; }
    if (sum == G) break;
    __builtin_amdgcn_s_sleep(1);
    if ((++sp & 255u) == 0u) { if (xb_ld(&bar[XB_TMO])) break; if (sp > XB_SPIN_CAP) { atomicAdd(&bar[XB_TMO], 1u); break; } }
  }
  nloc = mine > 0u ? mine : 1u; nx = cnt > 0u ? cnt : 1u;
}
DI void xcd_barrier(const XcdBarrier& b) {
  asm volatile("s_waitcnt vmcnt(0)" ::: "memory");
  __syncthreads();
  if (threadIdx.x == 0) {
    unsigned* bar = b.bar;
    __builtin_amdgcn_s_waitcnt(0);
    unsigned nloc = b.st[0], nx = b.st[1];
    if (nloc == 0u) { xcd_barrier_complete(bar, b.x, nloc, nx); b.st[0] = nloc; b.st[1] = nx; }
    const unsigned old = xb_add(&bar[XB_XSUB(b.x)], 1u);
    const unsigned gen = old / nloc;
    if (old + 1u == (gen + 1u) * nloc) {
      __builtin_amdgcn_fence(__ATOMIC_RELEASE, "agent");
      asm volatile("s_waitcnt vmcnt(0)" ::: "memory");
      const unsigned og = xb_add(&bar[XB_TOP], 1u);
      const unsigned tg = og / nx;
      if (og + 1u == (tg + 1u) * nx) xb_add(&bar[XB_TOPGEN], 1u);
      else XB_SPIN(xb_ld(&bar[XB_TOPGEN]) == tg, bar);
      __builtin_amdgcn_fence(__ATOMIC_ACQUIRE, "agent");
      xb_add(&bar[XB_XGEN(b.x)], 1u);
      asm volatile("s_waitcnt vmcnt(0)" ::: "memory");
    } else {
      XB_SPIN(xb_ld(&bar[XB_XGEN(b.x)]) == gen, bar);
      __builtin_amdgcn_fence(__ATOMIC_ACQUIRE, "agent");
      asm volatile("s_waitcnt vmcnt(0)" ::: "memory");
    }
  }
  __syncthreads();
}

constexpr int PH_PER_LAYER = 14, N_PHASES = 1 + 2 * PH_PER_LAYER;

DI void run_phase(const Params& pin, const int ph, LAS uchar* lds) {
  const int G = gridDim.x, c = blockIdx.x;
  int tid = threadIdx.x; asm volatile("" : "+v"(tid));
  Params p = pin; { size_t off = 0; asm volatile("" : "+s"(off)); p.ws = pin.ws + off; }
  if (ph == 0) {
    rownorm_phase(tid, p.x, nullptr, nullptr, nullptr, nullptr, nullptr, p.n_mix_pre, (bf16_t*)(p.ws + OFF_H));
    wconv_phase(tid, p, lds, 0, 2560, c, G);
    return;
  }
  const int l = (ph - 1) / PH_PER_LAYER, k = (ph - 1) % PH_PER_LAYER;
  uchar* wl = p.ws + OFF_W + (size_t)l * W_LAYER;
  switch (k) {
    case 0: {
      pg8::SchedStd S; S.init(p.ws + OFF_H, wl + WO_IN, MTOK, 3072, 1024, G, c);
      pg8::EpiG1a E{(bf16_t*)(p.ws + OFF_A), (bf16_t*)(p.ws + OFF_Z), (bf16_t*)(p.ws + OFF_C), (float*)(p.ws + OFF_E)};
      pg8::gemm_phase(tid, lds, 1024, S, E);
    } break;
    case 1: case 4: { const int pass = k == 1 ? 0 : 1; for (int it = c; it < 1024; it += G) dn_prep_item(tid, p, l, pass, it, lds); } break;
    case 2: case 5: { const int pass = k == 2 ? 0 : 1;
      if (c < 64) dn_scan_block(tid, p, pass, c, lds);
      else { for (int it = c - 64; it < 256; it += G - 64) attn_item(tid, p, l, pass * 256 + it, lds);
        if (l == 0) { if (pass == 0) wconv_phase(tid, p, lds, 2560, 7680, c - 64, G - 64); else wconv_phase(tid, p, lds, 7680, 15360, c - 64, G - 64); } }
    } break;
    case 3: case 6: { const int pass = k == 3 ? 0 : 1; dn_out_phase(tid, p, l, pass, lds); } break;
    case 7: {
      pg8::SchedStd S; S.init(p.ws + OFF_H, wl + WO_IN + (size_t)3072 * 1024 * 2, MTOK, 2048, 1024, G, c);
      pg8::EpiBf16<0> E{(bf16_t*)(p.ws + OFF_D), 2048};
      pg8::gemm_phase(tid, lds, 1024, S, E);
    } break;
    case 8: {
      pg8::SchedG2 S{(const char*)(p.ws + OFF_OA), (long)OFF_OB - (long)OFF_OA, (const char*)(wl + WO_UP), G, c};
      pg8::EpiG2 E{(const bf16_t*)(p.ws + OFF_D), (bf16_t*)(p.ws + OFF_T), (bf16_t*)(p.ws + OFF_H)};
      pg8::gemm_phase(tid, lds, 512, S, E);
    } break;
    case 9: {
      pg8::SchedStd S; S.init(p.ws + OFF_H, wl + WO_OUT, MTOK, 1024, 1024, G, c);
      pg8::EpiBf16<0> E{(bf16_t*)(p.ws + OFF_MIX), 1024};
      pg8::gemm_phase(tid, lds, 1024, S, E);
    } break;
    case 10: rownorm_phase(tid, l == 0 ? p.x : nullptr, l == 0 ? nullptr : (const bf16_t*)p.out, (const bf16_t*)(p.ws + OFF_MIX), p.n_mix_post + l * DM, nullptr, (bf16_t*)(p.ws + OFF_XB), p.n_mlp_pre + l * DM, (bf16_t*)(p.ws + OFF_H)); break;
    case 11: {
      pg8::SchedStd S; S.init(p.ws + OFF_H, wl + WO_W1, MTOK, 4096, 1024, G, c);
      pg8::EpiBf16<1> E{(bf16_t*)(p.ws + OFF_U), 4096};
      pg8::gemm_phase(tid, lds, 1024, S, E);
    } break;
    case 12: {
      pg8::SchedStd S; S.init(p.ws + OFF_U, wl + WO_W2, MTOK, 1024, 4096, G, c);
      pg8::EpiBf16<0> E{(bf16_t*)(p.ws + OFF_Y), 1024};
      pg8::gemm_phase(tid, lds, 4096, S, E);
    } break;
    case 13: rownorm_phase(tid, nullptr, (const bf16_t*)(p.ws + OFF_XB), (const bf16_t*)(p.ws + OFF_Y), p.n_mlp_post + l * DM, l == 0 ? nullptr : p.out, l == 0 ? (bf16_t*)p.out : nullptr,     l == 0 ? p.n_mix_pre + DM : nullptr, (bf16_t*)(p.ws + OFF_H)); break;
  }
}

__global__ void __launch_bounds__(512) mega(Params p, int ph_lo, int ph_hi) {
  extern __shared__ __attribute__((aligned(16))) uchar lds_raw[];
  LAS uchar* lds = (LAS uchar*)lds_raw;
  cg::grid_group grid = cg::this_grid();
  unsigned* bar = (unsigned*)(p.ws + OFF_BAR);
  volatile LAS unsigned* st = (volatile LAS unsigned*)(lds + LDS_ST_OFF);
  if (threadIdx.x < 2) st[threadIdx.x] = 0u;
  if (blockIdx.x == 0) for (int i = threadIdx.x; i < XCD_BAR_WORDS; i += 512) bar[i] = 0u;
  __syncthreads();
  XcdBarrier xb; xb.bar = bar; xb.x = 0; xb.st = st;
  for (int ph = ph_lo; ph <= ph_hi; ++ph) {
    int reps = 1;
#ifdef DUP_MASK
    if (ph > 0 && ((DUP_MASK >> ((ph - 1) % PH_PER_LAYER)) & 1)) reps = 2;
#endif
    for (int r = 0; r < reps; ++r) { if (r) __syncthreads(); run_phase(p, ph, lds); }
    if (ph < ph_hi) { if (ph == ph_lo) { grid.sync(); xb = xcd_barrier_post(bar, st); } else xcd_barrier(xb); }
  }
}

extern "C" void kernel_launch(void* const* d_in, const int* in_sizes, int n_in, void* d_out, int out_size, void* d_ws, size_t ws_size, hipStream_t stream) {
  static int grid_blocks = 0;
  if (!grid_blocks) {
    int dev = 0, cus = 0, per_cu = 0;
    (void)hipGetDevice(&dev);
    (void)hipDeviceGetAttribute(&cus, hipDeviceAttributeMultiprocessorCount, dev);
    (void)hipFuncSetAttribute((const void*)mega, hipFuncAttributeMaxDynamicSharedMemorySize, (int)kDynLds);
    (void)hipOccupancyMaxActiveBlocksPerMultiprocessor(&per_cu, mega, 512, kDynLds);
    if (per_cu < 1) fprintf(stderr, "occupancy query returned %d\n", per_cu);
    grid_blocks = cus;
    if (ws_size < WS_NEEDED) fprintf(stderr, "workspace too small: %zu\n", ws_size);
  }
  Params p{};
  p.x = (const float*)d_in[0]; p.w_in = (const float*)d_in[1]; p.conv_w = (const float*)d_in[2]; p.a_log = (const float*)d_in[3]; p.dt_bias = (const float*)d_in[4];
  p.dn_norm_w = (const float*)d_in[5]; p.attn_sink = (const float*)d_in[6]; p.w_up_a = (const float*)d_in[7]; p.w_up_b = (const float*)d_in[8]; p.w_out = (const float*)d_in[9];
  p.n_mix_pre = (const float*)d_in[10]; p.n_mix_post = (const float*)d_in[11]; p.n_mlp_pre = (const float*)d_in[12]; p.n_mlp_post = (const float*)d_in[13];
  p.w_mlp_in = (const float*)d_in[14]; p.w_mlp_out = (const float*)d_in[15];
  p.out = (float*)d_out; p.ws = (uchar*)d_ws;
  int lo = 0, hi = N_PHASES - 1;
  void* args[] = {&p, &lo, &hi};
  hipError_t e = hipLaunchCooperativeKernel((void*)mega, dim3(grid_blocks), dim3(512), args, kDynLds, stream);
  if (e != hipSuccess) fprintf(stderr, "cooperative launch failed: %s (grid %d)\n", hipGetErrorString(e), grid_blocks);
}
```

```cpp
#include <hip/hip_runtime.h>
#include <hip/hip_cooperative_groups.h>
#include <cstdio>
namespace cg = cooperative_groups;

#define DI __device__ __forceinline__
#define LAS __attribute__((address_space(3)))
typedef unsigned short bf16_t;
typedef unsigned char uchar;
typedef short bf16x8 __attribute__((ext_vector_type(8)));
typedef short bf16x4 __attribute__((ext_vector_type(4)));
typedef float f32x2 __attribute__((ext_vector_type(2)));
typedef float f32x4 __attribute__((ext_vector_type(4)));
typedef float f32x16 __attribute__((ext_vector_type(16)));
typedef unsigned u32x2 __attribute__((ext_vector_type(2)));
typedef unsigned u32x4 __attribute__((ext_vector_type(4)));
typedef __bf16 nbf2 __attribute__((ext_vector_type(2)));

constexpr int MTOK = 32768, DM = 1024, SEQ = 4096;
constexpr float EPS = 1e-6f;
constexpr size_t MiB = 1ull << 20;
constexpr size_t OFF_W = 0, W_LAYER = 30 * MiB;
constexpr size_t WO_IN = 0, WO_UP = 10 * MiB, WO_OUT = 12 * MiB, WO_W1 = 14 * MiB, WO_W2 = 22 * MiB;
constexpr size_t OFF_H = 60 * MiB;
constexpr size_t RB = 124 * MiB;
constexpr size_t OFF_A = RB, OFF_ST = RB, OFF_OB = RB + 32 * MiB, OFF_Z = RB + 96 * MiB, OFF_C = RB + 128 * MiB, OFF_E = RB + 176 * MiB,
                 OFF_GC = RB + 180 * MiB, OFF_QN = RB + 182 * MiB, OFF_KN = RB + 214 * MiB, OFF_WN = RB + 246 * MiB, OFF_KD = RB + 278 * MiB,
                 OFF_UT = RB + 310 * MiB, OFF_OA = RB + 342 * MiB, OFF_D = RB + 80 * MiB, OFF_T = RB + 208 * MiB, OFF_MIX = RB + 80 * MiB,
                 OFF_U = RB, OFF_Y = RB + 256 * MiB;
constexpr size_t WS_NEEDED = 512 * MiB;
constexpr size_t OFF_XB = RB + 320 * MiB;
constexpr size_t OFF_BAR = 508 * MiB;
constexpr unsigned LDS_ST_OFF = 136 * 1024 - 16;
constexpr size_t kDynLds = 136 * 1024;

struct Params {
  const float *x, *w_in, *conv_w, *a_log, *dt_bias, *dn_norm_w, *attn_sink, *w_up_a, *w_up_b, *w_out, *n_mix_pre, *n_mix_post, *n_mlp_pre,
      *n_mlp_post, *w_mlp_in, *w_mlp_out;
  float* out;
  uchar* ws;
};

DI float bf2f(bf16_t b) { return __uint_as_float(((unsigned)b) << 16); }
DI unsigned pk2(float lo, float hi) { f32x2 v = {lo, hi}; return __builtin_bit_cast(unsigned, __builtin_convertvector(v, nbf2)); }
DI bf16_t f2bf(float f) { return (bf16_t)(pk2(f, 0.f) & 0xffffu); }
DI bf16x8 pack8(f32x4 a, f32x4 b) { u32x4 w = {pk2(a[0], a[1]), pk2(a[2], a[3]), pk2(b[0], b[1]), pk2(b[2], b[3])}; return __builtin_bit_cast(bf16x8, w); }
DI bf16x8 cat4(bf16x4 lo, bf16x4 hi) { return __builtin_shufflevector(lo, hi, 0, 1, 2, 3, 4, 5, 6, 7); }
DI float wsum(float v) { for (int o = 32; o; o >>= 1) v += __shfl_xor(v, o); return v; }
DI float sigmoidf_(float x) { return __builtin_amdgcn_rcpf(1.0f + __expf(-x)); }
#define MFMA16(a, b, c) __builtin_amdgcn_mfma_f32_16x16x32_bf16((a), (b), (c), 0, 0, 0)
#define MFMA32(a, b, c) __builtin_amdgcn_mfma_f32_32x32x16_bf16((a), (b), (c), 0, 0, 0)

namespace pg8 {
constexpr int BM = 256, BK = 64, HALF = 128, HTB = HALF * BK * 2, NXCD = 8, WGM = 8;
DI int lds_byte(int r, int c) { const int st = (r >> 4) * 2 + (c >> 5), rr = r & 15, cc = c & 31, ob = rr * 64 + cc * 2; return st * 1024 + (ob ^ (((ob >> 9) & 1) << 5)); }
DI void stage_rc(int b, int& R, int& C) { const int st = b / 1024, sb = b % 1024, swz = sb ^ (((sb >> 9) & 1) << 5); R = (st >> 1) * 16 + swz / 64; C = (st & 1) * 32 + (swz % 64) / 2; }
DI int perm32(int rho) { const int n = rho >> 4, i = rho & 15; return 8 * (i >> 2) + 4 * n + (i & 3); }
struct Unit { int pm, pn, aux; const char* a; const char* b; };

struct SchedStd {
  const char* A; const char* Bt; int nM, nN, nwg, G, c; size_t tstep;
  DI void init(const void* A_, const void* Bt_, int M, int N, int K, int G_, int c_) { A = (const char*)A_; Bt = (const char*)Bt_; nM = M / BM; nN = N / BM; nwg = nM * nN; G = G_; c = c_; tstep = (size_t)BM * K * 2; }
  DI bool next(int i, Unit& u) const {
    const long L = (long)i * G + c; if (L >= nwg) return false;
    int wgid = (int)L; { const int q = nwg / NXCD, r = nwg % NXCD, xcd = wgid % NXCD, off = wgid / NXCD; wgid = (xcd < r ? xcd * (q + 1) : r * (q + 1) + (xcd - r) * q) + off; }
    const int nig = WGM * nN, gid = wgid / nig, fm = gid * WGM, gsz = (nM - fm) < WGM ? (nM - fm) : WGM;
    u.pm = fm + ((wgid % nig) % gsz); u.pn = (wgid % nig) / gsz; u.aux = 0; u.a = A + (size_t)u.pm * tstep; u.b = Bt + (size_t)u.pn * tstep; return true;
  }
};
struct SchedG2 {
  const char* oa; long dab; const char* wt; int G, c;
  DI bool next(int i, Unit& u) const {
    const int tile = (i >> 1) * G + c;
    const int half = i & 1; u.pm = tile >> 2; u.pn = tile & 3; u.aux = half;
    const size_t ts = (size_t)BM * 512 * 2;
    u.a = oa + (long)half * dab + (size_t)u.pm * ts; u.b = wt + (size_t)(half * 4 + u.pn) * ts; return tile < 512;
  }
};

template <class Epi, class Sched>
DI void gemm_phase(const int tid, LAS uchar* lds, const int K, const Sched& S, const Epi& E) {
  const int wid = __builtin_amdgcn_readfirstlane(tid >> 6), lane = tid & 63, wr = wid >> 2, wc = wid & 3, fr = lane & 15, fq = lane >> 4;
  const int nt = K / BK;
  unsigned voffA[2], voffB[2];
#pragma unroll
  for (int i = 0; i < 2; ++i) { int R, C; stage_rc(tid * 16 + i * 8192, R, C); const int Rb = Epi::PERM ? ((R & ~31) + perm32(R & 31)) : R;
    voffA[i] = (unsigned)(R * K + C) * 2u; voffB[i] = (unsigned)(Rb * K + C) * 2u; }
  const size_t kstep = (size_t)(BK * 2);
  const size_t hstep = (size_t)HALF * K * 2;
  const unsigned ldsw = (unsigned)wid * 1024u;
  const int aoff = lds_byte(wr * 64 + fr, fq * 8), boff = lds_byte(wc * 32 + fr, fq * 8);
#define PG8_SA(b, h) (((b) * 2 + (h)) * HTB)
#define PG8_SB(b, h) ((4 + (b) * 2 + (h)) * HTB)
#define PG8_STAGE(bufoff, gbase, voff) do { _Pragma("unroll") for (int _i = 0; _i < 2; ++_i) \
    __builtin_amdgcn_global_load_lds((const unsigned*)((const char*)(gbase) + (voff)[_i]), (LAS unsigned*)(lds + (bufoff) + ldsw + _i * 8192), 16, 0, 0); } while (0)
#define PG8_LDA(dst, b, h) do { _Pragma("unroll") for (int m = 0; m < 4; ++m) _Pragma("unroll") for (int k = 0; k < 2; ++k) dst[m][k] = *(const LAS bf16x8*)(lds + PG8_SA(b, h) + aoff + m * 2048 + k * 1024); } while (0)
#define PG8_LDB(dst, b, h) do { _Pragma("unroll") for (int n = 0; n < 2; ++n) _Pragma("unroll") for (int k = 0; k < 2; ++k) dst[n][k] = *(const LAS bf16x8*)(lds + PG8_SB(b, h) + boff + n * 2048 + k * 1024); } while (0)
#define PG8_MMA(ai, bj, At, Bt) do { __builtin_amdgcn_s_setprio(1); _Pragma("unroll") for (int m = 0; m < 4; ++m) _Pragma("unroll") for (int n = 0; n < 2; ++n) _Pragma("unroll") for (int k = 0; k < 2; ++k) \
    acc[ai][bj][m][n] = __builtin_amdgcn_mfma_f32_16x16x32_bf16(Bt[n][k], At[m][k], acc[ai][bj][m][n], 0, 0, 0); __builtin_amdgcn_s_setprio(0); } while (0)
#define PG8_WAIT_V(n) asm volatile("s_waitcnt vmcnt(" #n ")" ::: "memory")
#define PG8_WAIT_L(n) asm volatile("s_waitcnt lgkmcnt(" #n ")" ::: "memory")
#define PG8_BAR __builtin_amdgcn_s_barrier()
#define PG8_SCHED __builtin_amdgcn_sched_barrier(0)
  Unit cur, nxt; int ui = 0;
  if (!S.next(0, cur)) return;
  f32x4 acc[2][2][4][2];
#pragma unroll
  for (int a = 0; a < 2; ++a)
#pragma unroll
    for (int b = 0; b < 2; ++b)
#pragma unroll
      for (int m = 0; m < 4; ++m)
#pragma unroll
        for (int n = 0; n < 2; ++n) acc[a][b][m][n] = (f32x4){0.f, 0.f, 0.f, 0.f};
  bf16x8 At[4][2], B0[2][2], B1[2][2];
  const char* cA = cur.a; const char* cB = cur.b;
  PG8_STAGE(PG8_SB(0, 0), cB, voffB); PG8_STAGE(PG8_SA(0, 0), cA, voffA); PG8_STAGE(PG8_SB(0, 1), cB + hstep, voffB); PG8_STAGE(PG8_SA(0, 1), cA + hstep, voffA);
  if (wr == 1) PG8_BAR;
  PG8_WAIT_V(4); PG8_BAR;
  PG8_STAGE(PG8_SB(1, 0), cB + kstep, voffB); PG8_STAGE(PG8_SA(1, 0), cA + kstep, voffA); PG8_STAGE(PG8_SB(1, 1), cB + hstep + kstep, voffB);
  PG8_WAIT_V(6); PG8_BAR;
  for (;;) {
    const bool has_next = S.next(ui + 1, nxt);
    const char* nA = has_next ? nxt.a : cA; const char* nB = has_next ? nxt.b : cB;
    for (int t = 0; t < nt; t += 2) {
      const bool last = (t == nt - 2);
      const char* a1 = cA + (size_t)(t + 1) * kstep;
      const char* a2 = last ? nA : cA + (size_t)(t + 2) * kstep; const char* b2 = last ? nB : cB + (size_t)(t + 2) * kstep;
      const char* a3 = a2 + kstep; const char* b3 = b2 + kstep;
      PG8_LDB(B0, 0, 0); PG8_SCHED; PG8_LDA(At, 0, 0); PG8_STAGE(PG8_SA(1, 1), a1 + hstep, voffA);
      PG8_WAIT_L(8); PG8_BAR; PG8_WAIT_L(0); PG8_MMA(0, 0, At, B0); PG8_BAR; PG8_SCHED;
      PG8_LDB(B1, 0, 1); PG8_STAGE(PG8_SB(0, 0), b2, voffB);
      PG8_BAR; PG8_WAIT_L(0); PG8_MMA(0, 1, At, B1); PG8_BAR;
      PG8_LDA(At, 0, 1); PG8_STAGE(PG8_SA(0, 0), a2, voffA);
      PG8_BAR; PG8_WAIT_L(0); PG8_MMA(1, 0, At, B0); PG8_BAR; PG8_SCHED;
      PG8_STAGE(PG8_SB(0, 1), b2 + hstep, voffB);
      PG8_WAIT_V(6); PG8_BAR; PG8_MMA(1, 1, At, B1); PG8_BAR;
      PG8_LDB(B0, 1, 0); PG8_SCHED; PG8_LDA(At, 1, 0); PG8_STAGE(PG8_SA(0, 1), a2 + hstep, voffA);
      PG8_WAIT_L(8); PG8_BAR; PG8_WAIT_L(0); PG8_MMA(0, 0, At, B0); PG8_BAR; PG8_SCHED;
      PG8_LDB(B1, 1, 1); PG8_STAGE(PG8_SB(1, 0), b3, voffB);
      PG8_BAR; PG8_WAIT_L(0); PG8_MMA(0, 1, At, B1); PG8_BAR;
      PG8_LDA(At, 1, 1); PG8_STAGE(PG8_SA(1, 0), a3, voffA);
      PG8_BAR; PG8_WAIT_L(0); PG8_MMA(1, 0, At, B0); PG8_BAR; PG8_SCHED;
      PG8_STAGE(PG8_SB(1, 1), b3 + hstep, voffB);
      PG8_WAIT_V(6); PG8_BAR; PG8_MMA(1, 1, At, B1); PG8_BAR;
    }
    E(acc, cur, wr, wc, fr, fq);
    if (!has_next) break;
#pragma unroll
    for (int a = 0; a < 2; ++a)
#pragma unroll
      for (int b = 0; b < 2; ++b)
#pragma unroll
        for (int m = 0; m < 4; ++m)
#pragma unroll
          for (int n = 0; n < 2; ++n) acc[a][b][m][n] = (f32x4){0.f, 0.f, 0.f, 0.f};
    cur = nxt; cA = nA; cB = nB; ++ui;
  }
  PG8_WAIT_V(0);
  if (wr == 0) PG8_BAR;
  PG8_BAR;
#undef PG8_SA
#undef PG8_SB
#undef PG8_STAGE
#undef PG8_LDA
#undef PG8_LDB
#undef PG8_MMA
#undef PG8_WAIT_V
#undef PG8_WAIT_L
#undef PG8_BAR
#undef PG8_SCHED
}

struct EpiF32 {
  static constexpr bool PERM = false;
  float* C; int ldc;
  DI void operator()(const f32x4 (&acc)[2][2][4][2], const Unit& u, int wr, int wc, int fr, int fq) const {
    const int row0 = u.pm * BM + wr * 64 + fr, col0 = u.pn * BM + wc * 32 + 4 * fq;
#pragma unroll
    for (int ai = 0; ai < 2; ++ai)
#pragma unroll
      for (int m = 0; m < 4; ++m) { float* rowp = C + (size_t)(row0 + ai * HALF + m * 16) * ldc + col0;
#pragma unroll
        for (int bj = 0; bj < 2; ++bj)
#pragma unroll
          for (int n = 0; n < 2; ++n) *(f32x4*)(rowp + bj * HALF + n * 16) = acc[ai][bj][m][n]; }
  }
};
template <int ACT> struct EpiBf16 {
  static constexpr bool PERM = true;
  bf16_t* O; int ldc;
  DI void operator()(const f32x4 (&acc)[2][2][4][2], const Unit& u, int wr, int wc, int fr, int fq) const {
    const int row0 = u.pm * BM + wr * 64 + fr, col0 = u.pn * BM + wc * 32 + 8 * fq;
#pragma unroll
    for (int ai = 0; ai < 2; ++ai)
#pragma unroll
      for (int m = 0; m < 4; ++m) { bf16_t* rowp = O + (size_t)(row0 + ai * HALF + m * 16) * ldc + col0;
#pragma unroll
        for (int bj = 0; bj < 2; ++bj) { f32x4 v0 = acc[ai][bj][m][0], v1 = acc[ai][bj][m][1];
          if (ACT == 1) {
#pragma unroll
            for (int j = 0; j < 4; ++j) { float a = fmaxf(v0[j], 0.f), b = fmaxf(v1[j], 0.f); v0[j] = a * a; v1[j] = b * b; } }
          u32x4 w = {pk2(v0[0], v0[1]), pk2(v0[2], v0[3]), pk2(v1[0], v1[1]), pk2(v1[2], v1[3])};
          *(u32x4*)(rowp + bj * HALF) = w; } }
  }
};
struct EpiG1a {
  static constexpr bool PERM = true;
  bf16_t *A, *Z, *C; float* E;
  DI void operator()(const f32x4 (&acc)[2][2][4][2], const Unit& u, int wr, int wc, int fr, int fq) const {
    const int row0 = u.pm * BM + wr * 64 + fr; const int pn = u.pn;
    if (pn == 11) {
      if (wc == 0) {
#pragma unroll
        for (int ai = 0; ai < 2; ++ai)
#pragma unroll
          for (int m = 0; m < 4; ++m)
#pragma unroll
            for (int n = 0; n < 2; ++n) *(f32x4*)(E + (size_t)(row0 + ai * HALF + m * 16) * 32 + 8 * fq + 4 * n) = acc[ai][0][m][n];
      }
      return;
    }
    bf16_t* base; int ld, colt;
    if (pn < 6) { base = A; ld = 1536; colt = pn * 256; } else if (pn < 8) { base = Z; ld = 512; colt = (pn - 6) * 256; } else { base = C; ld = 768; colt = (pn - 8) * 256; }
    const int col0 = colt + wc * 32 + 8 * fq;
#pragma unroll
    for (int ai = 0; ai < 2; ++ai)
#pragma unroll
      for (int m = 0; m < 4; ++m) { bf16_t* rowp = base + (size_t)(row0 + ai * HALF + m * 16) * ld + col0;
#pragma unroll
        for (int bj = 0; bj < 2; ++bj) { const f32x4 v0 = acc[ai][bj][m][0], v1 = acc[ai][bj][m][1];
          u32x4 w = {pk2(v0[0], v0[1]), pk2(v0[2], v0[3]), pk2(v1[0], v1[1]), pk2(v1[2], v1[3])};
          *(u32x4*)(rowp + bj * HALF) = w; } }
  }
};
struct EpiG2 {
  static constexpr bool PERM = true;
  const bf16_t* D; bf16_t* T; bf16_t* Mo;
  DI void operator()(const f32x4 (&acc)[2][2][4][2], const Unit& u, int wr, int wc, int fr, int fq) const {
    const int row0 = u.pm * BM + wr * 64 + fr, col0 = u.pn * BM + wc * 32 + 8 * fq; const int half = u.aux;
#pragma unroll
    for (int ai = 0; ai < 2; ++ai) {
      u32x4 gw[4][2], tw[4][2];
#pragma unroll
      for (int m = 0; m < 4; ++m)
#pragma unroll
        for (int bj = 0; bj < 2; ++bj) { const size_t row = (size_t)(row0 + ai * HALF + m * 16); const int col = col0 + bj * HALF;
          gw[m][bj] = *(const u32x4*)(D + row * 2048 + half * 1024 + col);
          tw[m][bj] = (u32x4){0u, 0u, 0u, 0u};
          if (half) tw[m][bj] = *(const u32x4*)(T + row * 1024 + col); }
#pragma unroll
      for (int m = 0; m < 4; ++m)
#pragma unroll
        for (int bj = 0; bj < 2; ++bj) { const size_t row = (size_t)(row0 + ai * HALF + m * 16); const int col = col0 + bj * HALF;
          const u32x4 g = gw[m][bj], t = tw[m][bj];
          f32x4 v0 = acc[ai][bj][m][0], v1 = acc[ai][bj][m][1];
#pragma unroll
          for (int j = 0; j < 2; ++j) { v0[2 * j] *= sigmoidf_(__uint_as_float(g[j] << 16)); v0[2 * j + 1] *= sigmoidf_(__uint_as_float(g[j] & 0xffff0000u));
            v1[2 * j] *= sigmoidf_(__uint_as_float(g[2 + j] << 16)); v1[2 * j + 1] *= sigmoidf_(__uint_as_float(g[2 + j] & 0xffff0000u)); }
          v0[0] += __uint_as_float(t[0] << 16); v0[1] += __uint_as_float(t[0] & 0xffff0000u); v0[2] += __uint_as_float(t[1] << 16); v0[3] += __uint_as_float(t[1] & 0xffff0000u);
          v1[0] += __uint_as_float(t[2] << 16); v1[1] += __uint_as_float(t[2] & 0xffff0000u); v1[2] += __uint_as_float(t[3] << 16); v1[3] += __uint_as_float(t[3] & 0xffff0000u);
          const u32x4 w = {pk2(v0[0], v0[1]), pk2(v0[2], v0[3]), pk2(v1[0], v1[1]), pk2(v1[2], v1[3])};
          if (half == 0) *(u32x4*)(T + row * 1024 + col) = w; else *(u32x4*)(Mo + row * 1024 + col) = w; }
    }
  }
};
}

DI void rownorm_phase(const int tid, const float* xi, const bf16_t* xib, const bf16_t* y, const float* wpost, float* xo, bf16_t* xob, const float* wh, bf16_t* h) {
  const int lane = tid & 63, gw = blockIdx.x * 8 + (tid >> 6), nw = gridDim.x * 8;
  f32x4 wp[4], whv[4];
#pragma unroll
  for (int j = 0; j < 4; ++j) { wp[j] = wpost ? *(const f32x4*)(wpost + j * 256 + lane * 4) : (f32x4){0.f, 0.f, 0.f, 0.f}; whv[j] = wh ? *(const f32x4*)(wh + j * 256 + lane * 4) : (f32x4){0.f, 0.f, 0.f, 0.f}; }
  f32x4 nxf[4]; u32x2 nxb[4], nyb[4];
#define RN_ISSUE(row_) do { _Pragma("unroll") for (int j = 0; j < 4; ++j) { const size_t o_ = (size_t)(row_) * DM + j * 256 + lane * 4; \
      nxf[j] = (f32x4){0.f, 0.f, 0.f, 0.f}; nxb[j] = (u32x2){0u, 0u}; nyb[j] = (u32x2){0u, 0u}; \
      if (xib) nxb[j] = *(const u32x2*)(xib + o_); else nxf[j] = *(const f32x4*)(xi + o_); \
      if (y) nyb[j] = *(const u32x2*)(y + o_); } } while (0)
  int row = gw;
  if (row < MTOK) RN_ISSUE(row);
  for (; row < MTOK; row += nw) {
    f32x4 xv[4], yv[4];
#pragma unroll
    for (int j = 0; j < 4; ++j) {
      xv[j] = xib ? (f32x4){__uint_as_float(nxb[j][0] << 16), __uint_as_float(nxb[j][0] & 0xffff0000u), __uint_as_float(nxb[j][1] << 16), __uint_as_float(nxb[j][1] & 0xffff0000u)} : nxf[j];
      yv[j] = (f32x4){__uint_as_float(nyb[j][0] << 16), __uint_as_float(nyb[j][0] & 0xffff0000u), __uint_as_float(nyb[j][1] << 16), __uint_as_float(nyb[j][1] & 0xffff0000u)};
    }
    if (row + nw < MTOK) RN_ISSUE(row + nw);
    if (y) {
      float ss = 0.f;
#pragma unroll
      for (int j = 0; j < 4; ++j) ss += yv[j][0] * yv[j][0] + yv[j][1] * yv[j][1] + yv[j][2] * yv[j][2] + yv[j][3] * yv[j][3];
      const float r = rsqrtf(wsum(ss) * (1.0f / DM) + EPS);
#pragma unroll
      for (int j = 0; j < 4; ++j) { xv[j] += yv[j] * r * wp[j];
        if (xob) { u32x2 o = {pk2(xv[j][0], xv[j][1]), pk2(xv[j][2], xv[j][3])}; *(u32x2*)(xob + (size_t)row * DM + j * 256 + lane * 4) = o; }
        else *(f32x4*)(xo + (size_t)row * DM + j * 256 + lane * 4) = xv[j]; }
    }
    if (wh) {
      float ss = 0.f;
#pragma unroll
      for (int j = 0; j < 4; ++j) ss += xv[j][0] * xv[j][0] + xv[j][1] * xv[j][1] + xv[j][2] * xv[j][2] + xv[j][3] * xv[j][3];
      const float r = rsqrtf(wsum(ss) * (1.0f / DM) + EPS);
#pragma unroll
      for (int j = 0; j < 4; ++j) { const f32x4 v = xv[j] * r * whv[j];
        u32x2 o = {pk2(v[0], v[1]), pk2(v[2], v[3])}; *(u32x2*)(h + (size_t)row * DM + j * 256 + lane * 4) = o; }
    }
  }
#undef RN_ISSUE
}

DI void wconv_phase(const int tid, const Params& p, LAS uchar* lds, const int t_begin, const int t_end, const int cidx, const int cnum) {
  LAS float* tile = (LAS float*)lds;
  constexpr int T_IN = 160 * 16, T_UP = 64 * 8, T_OUT = 32 * 16, T_W1 = 128 * 16, T_W2 = 32 * 64, T_L = T_IN + T_UP + T_OUT + T_W1 + T_W2;
  for (int t = t_begin + cidx; t < t_end; t += cnum) {
    const int l = t / T_L; int r = t % T_L;
    const float* src; int ldn, K, nsrc0, k0, r0; bf16_t* dst;
    uchar* wl = p.ws + OFF_W + (size_t)l * W_LAYER;
    if (r < T_IN) { const int rt = r / 16, kt = r % 16; r0 = rt * 32; k0 = kt * 64; K = 1024; ldn = 4896; src = p.w_in + (size_t)l * 1024 * 4896; dst = (bf16_t*)(wl + WO_IN);
      nsrc0 = r0 < 2048 ? r0 : r0 < 2816 ? r0 + 32 : r0 < 2848 ? 2048 + (r0 - 2816) : r0 < 3072 ? -1 : 2848 + (r0 - 3072); }
    else if ((r -= T_IN) < T_UP) { const int rt = r / 8, kt = r % 8; r0 = rt * 32; k0 = kt * 64; K = 512; ldn = 1024; dst = (bf16_t*)(wl + WO_UP);
      if (r0 < 1024) { src = p.w_up_a + (size_t)l * 512 * 1024; nsrc0 = r0; } else { src = p.w_up_b + (size_t)l * 512 * 1024; nsrc0 = r0 - 1024; } }
    else if ((r -= T_UP) < T_OUT) { const int rt = r / 16, kt = r % 16; r0 = rt * 32; k0 = kt * 64; K = 1024; ldn = 1024; src = p.w_out + (size_t)l * 1024 * 1024; dst = (bf16_t*)(wl + WO_OUT); nsrc0 = r0; }
    else if ((r -= T_OUT) < T_W1) { const int rt = r / 16, kt = r % 16; r0 = rt * 32; k0 = kt * 64; K = 1024; ldn = 4096; src = p.w_mlp_in + (size_t)l * 1024 * 4096; dst = (bf16_t*)(wl + WO_W1); nsrc0 = r0; }
    else { r -= T_W1; const int rt = r / 64, kt = r % 64; r0 = rt * 32; k0 = kt * 64; K = 4096; ldn = 1024; src = p.w_mlp_out + (size_t)l * 4096 * 1024; dst = (bf16_t*)(wl + WO_W2); nsrc0 = r0; }
    { const int kk = tid >> 3, n4 = (tid & 7) * 4;
      f32x4 v = {0.f, 0.f, 0.f, 0.f};
      if (nsrc0 >= 0) v = *(const f32x4*)(src + (size_t)(k0 + kk) * ldn + nsrc0 + n4);
#pragma unroll
      for (int e = 0; e < 4; ++e) tile[(n4 + e) * 65 + kk] = v[e]; }
    __syncthreads();
    { const int n = tid >> 4, k4 = (tid & 15) * 4;
      const float a = tile[n * 65 + k4], b = tile[n * 65 + k4 + 1], c = tile[n * 65 + k4 + 2], d = tile[n * 65 + k4 + 3];
      u32x2 o = {pk2(a, b), pk2(c, d)};
      *(u32x2*)(dst + (size_t)(r0 + n) * K + k0 + k4) = o; }
    __syncthreads();
  }
}

constexpr unsigned PL_KV = 0, PL_LB = 36864, PL_SM = 110592, PL_KN = 114688, PL_LSTRIDE = 16400;
template <int JB> DI void tri_inv_cols(const LAS float* Lm, const int cl, float (&X)[64]) {
#pragma unroll
  for (int i = 16 * JB; i < 64; ++i) {
    float r0 = (i - 16 * JB == cl) ? 1.0f : 0.0f, r1 = 0.f;
    const LAS float* Li = Lm;
    if (i >= 16 * JB + 3) asm volatile("" : "+v"(Li), "+v"(X[i - 3]));
#pragma unroll
    for (int j4 = 16 * JB; j4 < i; j4 += 4) { const f32x4 lv = *(const LAS f32x4*)(Li + i * 64 + j4);
      r0 -= lv[0] * X[j4]; r1 -= lv[1] * X[j4 + 1]; r0 -= lv[2] * X[j4 + 2]; r1 -= lv[3] * X[j4 + 3]; }
    X[i] = r0 + r1;
  }
}
#define RELAUNDER() int tid = tid_in; asm volatile("" : "+v"(tid)); const int lane = tid & 63, wid = __builtin_amdgcn_readfirstlane(tid >> 6); (void)lane; (void)wid
DI void tri_inv32(const LAS float* Lb, const int c, float (&X)[32]) {
#pragma unroll
  for (int i = 0; i < 32; ++i) {
    float r0 = (i == c) ? 1.0f : 0.0f, r1 = 0.f;
    const LAS float* Li = Lb;
    if (i >= 3) asm volatile("" : "+v"(Li), "+v"(X[i - 3]));
#pragma unroll
    for (int j4 = 0; j4 < i; j4 += 4) { const f32x4 lv = *(const LAS f32x4*)(Li + i * 64 + j4);
      r0 -= lv[0] * X[j4]; r1 -= lv[1] * X[j4 + 1]; r0 -= lv[2] * X[j4 + 2]; r1 -= lv[3] * X[j4 + 3]; }
    X[i] = r0 + r1;
  }
}
DI void dn_prep_item(const int tid_in, const Params& p, const int l, const int pass, const int item, LAS uchar* lds) {
  const int hp = item & 3, c = (item >> 2) & 63, bl = item >> 8, b = pass * 4 + bl;
  const size_t t0 = (size_t)b * SEQ + c * 64;
  const bf16_t* Ab = (const bf16_t*)(p.ws + OFF_A);
  const float* Eb = (const float*)(p.ws + OFF_E);
  bf16_t* QN = (bf16_t*)(p.ws + OFF_QN); bf16_t* KN = (bf16_t*)(p.ws + OFF_KN);
  bf16_t* WN = (bf16_t*)(p.ws + OFF_WN); bf16_t* KD = (bf16_t*)(p.ws + OFF_KD); bf16_t* UT = (bf16_t*)(p.ws + OFF_UT);
  float* GC = (float*)(p.ws + OFF_GC);
  LAS float* sm = (LAS float*)(lds + PL_SM);
  LAS float* gcs = sm; LAS float* bet = sm + 256; LAS float* sclw = sm + 512;
  { RELAUNDER();
    u32x4 st[7];
#pragma unroll
    for (int it = 0; it < 7; ++it) {
      const int idx = it * 512 + tid, row = idx / 48, pc = idx - row * 48, sel = pc >> 3, g8 = pc & 7, hs = sel / 3, which = sel - hs * 3;
      const int sp = c * 64 + row - 2;
      st[it] = (u32x4){0u, 0u, 0u, 0u};
      if (idx < 68 * 48 && sp >= 0 && sp < SEQ) st[it] = *(const u32x4*)(Ab + ((size_t)b * SEQ + sp) * 1536 + which * 512 + (hp * 2 + hs) * 64 + g8 * 8);
    }
#pragma unroll
    for (int it = 0; it < 7; ++it) { const int idx = it * 512 + tid, row = idx / 48, pc = idx - row * 48; if (idx < 68 * 48) *(LAS u32x4*)(lds + PL_LB + row * 784 + pc * 16) = st[it]; }
  }
  __syncthreads();
  { RELAUNDER();
  if (wid >= 6) {
#pragma unroll 1
    for (int mm = 0; mm < 2; ++mm) {
      const int mat = (wid - 6) * 2 + mm, hs = mat >> 1, dir = mat & 1, i = lane, h = hp * 2 + hs;
      const size_t tok = t0 + (dir ? 63 - i : i);
      const float a = Eb[tok * 32 + dir * 8 + h], be = Eb[tok * 32 + 16 + dir * 8 + h];
      const float xg = a + p.dt_bias[l * 16 + dir * 8 + h];
      const float sp = xg > 20.f ? xg : log1pf(__expf(xg));
      float s = -__expf(p.a_log[l * 16 + dir * 8 + h]) * sp;
#pragma unroll
      for (int o = 1; o < 64; o <<= 1) { const float t = __shfl_up(s, o); if (lane >= o) s += t; }
      const float beta = sigmoidf_(be);
      gcs[mat * 64 + i] = s; bet[mat * 64 + i] = beta; sclw[mat * 64 + i] = beta * __expf(s);
      GC[((((size_t)b * 8 + h) * 2 + dir) * 64 + (dir ? 63 - c : c)) * 64 + i] = s;
    }
  } else {
    const int g8 = tid & 7, r48 = tid >> 3, sel = r48 % 6, tg = r48 / 6, hs = sel / 3, which = sel - hs * 3, h = hp * 2 + hs;
    const int ch0 = which * 512 + h * 64 + g8 * 8;
    f32x4 w0[5], w1[5];
#pragma unroll
    for (int j = 0; j < 5; ++j) { const float* wp = p.conv_w + ((size_t)l * 5 + j) * 1536 + ch0; w0[j] = *(const f32x4*)wp; w1[j] = *(const f32x4*)(wp + 4); }
    u32x4 in[12];
#pragma unroll
    for (int r = 0; r < 12; ++r) in[r] = *(const LAS u32x4*)(lds + PL_LB + (8 * tg + r) * 784 + sel * 128 + g8 * 16);
#pragma unroll
    for (int t = 0; t < 8; ++t) {
      const int tok = 8 * tg + t;
      float acc[8];
#pragma unroll
      for (int e = 0; e < 8; ++e) acc[e] = 0.f;
#pragma unroll
      for (int j = 0; j < 5; ++j) { const u32x4 iv = in[t + j];
        acc[0] += w0[j][0] * __uint_as_float(iv[0] << 16); acc[1] += w0[j][1] * __uint_as_float(iv[0] & 0xffff0000u);
        acc[2] += w0[j][2] * __uint_as_float(iv[1] << 16); acc[3] += w0[j][3] * __uint_as_float(iv[1] & 0xffff0000u);
        acc[4] += w1[j][0] * __uint_as_float(iv[2] << 16); acc[5] += w1[j][1] * __uint_as_float(iv[2] & 0xffff0000u);
        acc[6] += w1[j][2] * __uint_as_float(iv[3] << 16); acc[7] += w1[j][3] * __uint_as_float(iv[3] & 0xffff0000u); }
      float ss = 0.f;
#pragma unroll
      for (int e = 0; e < 8; ++e) { acc[e] = acc[e] * __builtin_amdgcn_rcpf(1.0f + __expf(-acc[e])); ss += acc[e] * acc[e]; }
      if (which < 2) {
        ss += __shfl_xor(ss, 1); ss += __shfl_xor(ss, 2); ss += __shfl_xor(ss, 4);
        const float r = rsqrtf(ss + EPS) * (which == 0 ? 0.125f : 1.0f);
#pragma unroll
        for (int e = 0; e < 8; ++e) acc[e] *= r;
      }
      const u32x4 o = {pk2(acc[0], acc[1]), pk2(acc[2], acc[3]), pk2(acc[4], acc[5]), pk2(acc[6], acc[7])};
      if (which < 2) *(u32x4*)((which == 0 ? QN : KN) + (t0 + tok) * 512 + h * 64 + g8 * 8) = o;
      if (which == 1) *(LAS u32x4*)(lds + PL_KN + hs * 9216 + tok * 144 + g8 * 16) = o;
      if (which >= 1) {
        LAS bf16_t* d = (LAS bf16_t*)(lds + PL_KV + hs * 18432 + (which == 2 ? 9216 : 0)) + (g8 * 8) * 72 + tok;
#pragma unroll
        for (int e = 0; e < 4; ++e) { d[(2 * e) * 72] = (bf16_t)(o[e] & 0xffffu); d[(2 * e + 1) * 72] = (bf16_t)(o[e] >> 16); }
      }
    }
  }
  }
  __syncthreads();
  { RELAUNDER();
    const int hs = wid >> 2, tm = (wid >> 1) & 1, tn = wid & 1, h = hp * 2 + hs, r31 = lane & 31, hh = lane >> 5;
    f32x16 kk;
#pragma unroll
    for (int r = 0; r < 16; ++r) kk[r] = 0.f;
#pragma unroll
    for (int s = 0; s < 4; ++s) {
      const bf16x8 a = *(const LAS bf16x8*)(lds + PL_KN + hs * 9216 + (32 * tm + r31) * 144 + 32 * s + 16 * hh);
      const bf16x8 bb = *(const LAS bf16x8*)(lds + PL_KN + hs * 9216 + (32 * tn + r31) * 144 + 32 * s + 16 * hh);
      kk = MFMA32(a, bb, kk);
    }
    LAS float* Lf = (LAS float*)(lds + PL_LB + (hs * 2) * PL_LSTRIDE); LAS float* Lb = (LAS float*)(lds + PL_LB + (hs * 2 + 1) * PL_LSTRIDE);
    const LAS float* gcf = gcs + hs * 128; const LAS float* gcb = gcf + 64; const LAS float* bf_ = bet + hs * 128; const LAS float* bb_ = bf_ + 64;
    const int col = 32 * tn + r31;
#pragma unroll
    for (int r = 0; r < 16; ++r) {
      const int row = 32 * tm + (r & 3) + 8 * (r >> 2) + 4 * hh; const float val = kk[r];
      const int ib = 63 - row, jb = 63 - col;
      const float lf = row > col ? bf_[row] * val * __expf(gcf[row] - gcf[col]) : 0.f;
      const float lb = row < col ? bb_[ib] * val * __expf(gcb[ib] - gcb[jb]) : 0.f;
      Lf[row * 64 + col] = lf; Lb[ib * 64 + jb] = lb;
    }
  }
  __syncthreads();
  float X[32]; f32x16 t21;
#pragma unroll
  for (int i = 0; i < 32; ++i) X[i] = 0.f;
#pragma unroll
  for (int r = 0; r < 16; ++r) t21[r] = 0.f;
  { RELAUNDER();
  if (wid < 4) {
    const int mat = wid, blk = lane >> 5, c = lane & 31, hh = blk;
    const LAS float* Lm = (const LAS float*)(lds + PL_LB + mat * PL_LSTRIDE);
    tri_inv32(Lm + blk * (32 * 64 + 32), c, X);
    LAS uchar* sg = lds + PL_KN + mat * 4096;
    if (blk == 0) {
#pragma unroll
      for (int g = 0; g < 4; ++g) { u32x4 o = {pk2(X[8 * g], X[8 * g + 1]), pk2(X[8 * g + 2], X[8 * g + 3]), pk2(X[8 * g + 4], X[8 * g + 5]), pk2(X[8 * g + 6], X[8 * g + 7])}; *(LAS u32x4*)(sg + c * 64 + g * 16) = o; }
    } else {
#pragma unroll
      for (int i = 0; i < 32; ++i) *(LAS bf16_t*)(sg + 2048 + i * 64 + c * 2) = f2bf(X[i]);
    }
    asm volatile("s_waitcnt lgkmcnt(0)" ::: "memory");
    f32x16 pacc;
#pragma unroll
    for (int r = 0; r < 16; ++r) pacc[r] = 0.f;
#pragma unroll
    for (int s = 0; s < 2; ++s) {
      const LAS float* la = Lm + (32 + c) * 64 + 16 * s + 8 * hh;
      const f32x4 l0 = *(const LAS f32x4*)la, l1 = *(const LAS f32x4*)(la + 4);
      const bf16x8 af = pack8(l0, l1);
      const bf16x8 bfr = *(const LAS bf16x8*)(sg + c * 64 + (16 * s + 8 * hh) * 2);
      pacc = MFMA32(af, bfr, pacc);
    }
#pragma unroll
    for (int s = 0; s < 2; ++s) {
      u32x4 w = {pk2(pacc[8 * s], pacc[8 * s + 1]), pk2(pacc[8 * s + 2], pacc[8 * s + 3]), pk2(pacc[8 * s + 4], pacc[8 * s + 5]), pk2(pacc[8 * s + 6], pacc[8 * s + 7])};
      const bf16x8 pb = __builtin_bit_cast(bf16x8, w);
      const LAS uchar* ta = sg + 2048 + c * 64 + (16 * s + 4 * hh) * 2;
      const bf16x8 af = cat4(*(const LAS bf16x4*)ta, *(const LAS bf16x4*)(ta + 16));
      t21 = MFMA32(af, pb, t21);
    }
  } else {
    const int tt = tid - 256, mat = tt >> 6, k = tt & 63, hs = mat >> 1, dir = mat & 1, h = hp * 2 + hs;
    const LAS bf16_t* kT = (const LAS bf16_t*)(lds + PL_KV + hs * 18432) + k * 72;
    const LAS float* gcd = gcs + mat * 64; const float gl = gcd[63];
    const size_t cid = (((size_t)bl * 8 + h) * 2 + dir) * 64 + (dir ? 63 - c : c);
    bf16_t* dst = KD + cid * 4096 + k * 64;
#pragma unroll
    for (int i8 = 0; i8 < 8; ++i8) {
      const u32x4 kv = *(const LAS u32x4*)(kT + (dir ? 56 - 8 * i8 : 8 * i8));
      float v[8];
#pragma unroll
      for (int e = 0; e < 4; ++e) { v[2 * e] = __uint_as_float(kv[e] << 16); v[2 * e + 1] = __uint_as_float(kv[e] & 0xffff0000u); }
      float o[8];
#pragma unroll
      for (int e = 0; e < 8; ++e) o[e] = (dir ? v[7 - e] : v[e]) * __expf(gl - gcd[8 * i8 + e]);
      u32x4 ov = {pk2(o[0], o[1]), pk2(o[2], o[3]), pk2(o[4], o[5]), pk2(o[6], o[7])};
      *(u32x4*)(dst + 8 * i8) = ov;
    }
  }
  }
  __syncthreads();
  { RELAUNDER();
  if (wid < 4) {
    const int mat = wid, blk = lane >> 5, c = lane & 31, hh = blk, dir = mat & 1, cc = 32 * blk + c;
    LAS bf16_t* Tb = (LAS bf16_t*)(lds + PL_LB + mat * 18432);
    {
      const float su = bet[mat * 64 + cc], sw = sclw[mat * 64 + cc];
      const int tc = dir ? 63 - cc : cc;
#pragma unroll
      for (int i = 0; i < 32; ++i) { const int gi = 32 * blk + i, ti = dir ? 63 - gi : gi; Tb[ti * 72 + tc] = f2bf(X[i] * su); Tb[4608 + ti * 72 + tc] = f2bf(X[i] * sw); }
      if (blk == 1) {
#pragma unroll
        for (int i = 0; i < 32; ++i) { const int ti = dir ? 63 - i : i; Tb[ti * 72 + tc] = 0; Tb[4608 + ti * 72 + tc] = 0; }
      }
    }
    {
      const float su = bet[mat * 64 + c], sw = sclw[mat * 64 + c];
      const int tc = dir ? 63 - c : c;
#pragma unroll
      for (int r = 0; r < 16; ++r) { const int gi = 32 + (r & 3) + 8 * (r >> 2) + 4 * hh, ti = dir ? 63 - gi : gi; const float v = -t21[r];
        Tb[ti * 72 + tc] = f2bf(v * su); Tb[4608 + ti * 72 + tc] = f2bf(v * sw); }
    }
  }
  }
  __syncthreads();
  { RELAUNDER();
    const int mat = wid >> 1, which = wid & 1, hs = mat >> 1, dir = mat & 1, h = hp * 2 + hs, col = lane & 15, q = lane >> 4;
    const size_t cid = (((size_t)bl * 8 + h) * 2 + dir) * 64 + (dir ? 63 - c : c);
    const LAS bf16_t* Tm = (const LAS bf16_t*)(lds + PL_LB + mat * 18432 + which * 9216) + col * 72 + 8 * q;
    const LAS bf16_t* Xm = (const LAS bf16_t*)(lds + PL_KV + hs * 18432 + (which ? 0 : 9216)) + col * 72 + 8 * q;
    bf16x8 tf[4][2], xf[4][2];
#pragma unroll
    for (int m = 0; m < 4; ++m)
#pragma unroll
      for (int s = 0; s < 2; ++s) { tf[m][s] = *(const LAS bf16x8*)(Tm + m * 16 * 72 + 32 * s); xf[m][s] = *(const LAS bf16x8*)(Xm + m * 16 * 72 + 32 * s); }
    if (which == 0) {
      bf16_t* dst = UT + cid * 4096;
#pragma unroll
      for (int mi = 0; mi < 4; ++mi)
#pragma unroll
        for (int nd = 0; nd < 4; ++nd) {
          f32x4 acc = {0.f, 0.f, 0.f, 0.f};
          acc = MFMA16(tf[mi][0], xf[nd][0], acc); acc = MFMA16(tf[mi][1], xf[nd][1], acc);
          const int ti = 16 * mi + 4 * q;
          if (dir) { u32x2 o = {pk2(acc[3], acc[2]), pk2(acc[1], acc[0])}; *(u32x2*)(dst + (16 * nd + col) * 64 + 60 - ti) = o; }
          else { u32x2 o = {pk2(acc[0], acc[1]), pk2(acc[2], acc[3])}; *(u32x2*)(dst + (16 * nd + col) * 64 + ti) = o; }
        }
    } else {
      bf16_t* dst = WN + cid * 4096;
#pragma unroll
      for (int ni = 0; ni < 4; ++ni)
#pragma unroll
        for (int m = 0; m < 4; ++m) {
          f32x4 acc = {0.f, 0.f, 0.f, 0.f};
          acc = MFMA16(xf[m][0], tf[ni][0], acc); acc = MFMA16(xf[m][1], tf[ni][1], acc);
          const int ti = 16 * ni + col, pi = dir ? 63 - ti : ti;
          u32x2 o = {pk2(-acc[0], -acc[1]), pk2(-acc[2], -acc[3])}; *(u32x2*)(dst + pi * 64 + 16 * m + 4 * q) = o;
        }
    }
  }
  __syncthreads();
}

DI void dn_scan_block(const int tid, const Params& p, const int pass, const int grp, LAS uchar* lds) {
  const int lane = tid & 63, wid = tid >> 6, col = lane & 15, q = lane >> 4, sl = wid & 3;
  const uchar* wn = p.ws + OFF_WN + (size_t)grp * 64 * 8192 + tid * 16;
  const uchar* kd = p.ws + OFF_KD + (size_t)grp * 64 * 8192 + tid * 16;
  const uchar* utl = p.ws + OFF_UT + (size_t)grp * 64 * 8192 + tid * 16;
  bf16_t* ut = (bf16_t*)(p.ws + OFF_UT) + (size_t)grp * 64 * 4096 + (16 * sl + col) * 64 + 4 * q;
  bf16_t* st2 = (bf16_t*)(p.ws + OFF_ST) + (size_t)grp * 64 * 4096 + (16 * sl) * 64;
  bf16_t* ut2 = (bf16_t*)(p.ws + OFF_UT) + (size_t)grp * 64 * 4096 + (16 * sl) * 64;
  const float* gcp = (const float*)(p.ws + OFF_GC) + ((size_t)pass * 64 + grp) * 64 * 64 + 63;
  const unsigned ldst = (tid >> 3) * 144 + (tid & 7) * 16;
  const unsigned aoff = col * 144 + 8 * q, uoff = 18432 + (16 * sl + col) * 144 + 8 * q;
  u32x4 rq[4][3]; float gq[4];
#pragma unroll
  for (int j = 0; j < 4; ++j) { rq[j][0] = *(const u32x4*)(wn + (size_t)j * 8192); rq[j][1] = *(const u32x4*)(kd + (size_t)j * 8192); rq[j][2] = *(const u32x4*)(utl + (size_t)j * 8192); gq[j] = gcp[j * 64]; }
  f32x4 S[4];
#pragma unroll
  for (int m = 0; m < 4; ++m) S[m] = (f32x4){0.f, 0.f, 0.f, 0.f};
#pragma unroll 1
  for (int n0 = 0; n0 < 64; n0 += 4) {
#pragma unroll
    for (int j = 0; j < 4; ++j) {
      const int n = n0 + j;
      LAS uchar* base = lds + (j & 1) * 27648;
      *(LAS u32x4*)(base + ldst) = rq[j][0]; *(LAS u32x4*)(base + 9216 + ldst) = rq[j][1]; *(LAS u32x4*)(base + 18432 + ldst) = rq[j][2];
      const float gl = gq[j];
      if (n0 + 4 < 64) { rq[j][0] = *(const u32x4*)(wn + (size_t)(n + 4) * 8192); rq[j][1] = *(const u32x4*)(kd + (size_t)(n + 4) * 8192); rq[j][2] = *(const u32x4*)(utl + (size_t)(n + 4) * 8192); gq[j] = gcp[(n + 4) * 64]; }
      __syncthreads();
      if (wid < 4) {
        const float e = __expf(gl);
        bf16x8 Sb[2];
#pragma unroll
        for (int s = 0; s < 2; ++s) Sb[s] = pack8(S[2 * s], S[2 * s + 1]);
        f32x4 vn[4];
#pragma unroll
        for (int m = 0; m < 4; ++m) {
          const bf16x4 ub = *(const LAS bf16x4*)(base + uoff + 32 * m);
          vn[m] = (f32x4){bf2f((bf16_t)ub[0]), bf2f((bf16_t)ub[1]), bf2f((bf16_t)ub[2]), bf2f((bf16_t)ub[3])};
#pragma unroll
          for (int s = 0; s < 2; ++s) { const LAS uchar* pa = base + aoff + m * 2304 + 64 * s;
            vn[m] = MFMA16(cat4(*(const LAS bf16x4*)pa, *(const LAS bf16x4*)(pa + 32)), Sb[s], vn[m]); }
        }
        bf16x8 Vb[2];
#pragma unroll
        for (int s = 0; s < 2; ++s) Vb[s] = pack8(vn[2 * s], vn[2 * s + 1]);
        {
          LAS uchar* my = lds + 55296 + wid * 4608;
#pragma unroll
          for (int m = 0; m < 4; ++m) { const u32x4 sw = __builtin_bit_cast(u32x4, Sb[m >> 1]), vw = __builtin_bit_cast(u32x4, Vb[m >> 1]);
            u32x2 so = {sw[2 * (m & 1)], sw[2 * (m & 1) + 1]}, vo = {vw[2 * (m & 1)], vw[2 * (m & 1) + 1]};
            *(LAS u32x2*)(my + col * 144 + (16 * m + 4 * q) * 2) = so; *(LAS u32x2*)(my + 2304 + col * 144 + (16 * m + 4 * q) * 2) = vo; }
          asm volatile("s_waitcnt lgkmcnt(0)" ::: "memory");
          const int rr = lane >> 2, sg = lane & 3;
          const u32x4 a0 = *(const LAS u32x4*)(my + rr * 144 + sg * 32), a1 = *(const LAS u32x4*)(my + rr * 144 + sg * 32 + 16);
          const u32x4 b0 = *(const LAS u32x4*)(my + 2304 + rr * 144 + sg * 32), b1 = *(const LAS u32x4*)(my + 2304 + rr * 144 + sg * 32 + 16);
          bf16_t* sdst = st2 + (size_t)n * 4096 + rr * 64 + sg * 16; bf16_t* vdst = ut2 + (size_t)n * 4096 + rr * 64 + sg * 16;
          *(u32x4*)sdst = a0; *(u32x4*)(sdst + 8) = a1; *(u32x4*)vdst = b0; *(u32x4*)(vdst + 8) = b1;
          asm volatile("" ::: "memory");
        }
#pragma unroll
        for (int m = 0; m < 4; ++m) { S[m] *= e;
#pragma unroll
          for (int s = 0; s < 2; ++s) { const LAS uchar* pa = base + 9216 + aoff + m * 2304 + 64 * s;
            S[m] = MFMA16(cat4(*(const LAS bf16x4*)pa, *(const LAS bf16x4*)(pa + 32)), Vb[s], S[m]); } }
      }
    }
  }
}

DI void dn_out_item(const int tid, const Params& p, const int l, const int pass, const int item, LAS uchar* lds) {
  const int lane = tid & 63, wid = tid >> 6, col = lane & 15, q = lane >> 4;
  const int h = item & 7, c = (item >> 3) & 63, bl = item >> 9, b = pass * 4 + bl;
  const size_t t0 = (size_t)b * SEQ + c * 64;
  const bf16_t* QN = (const bf16_t*)(p.ws + OFF_QN); const bf16_t* KN = (const bf16_t*)(p.ws + OFF_KN);
  const bf16_t* ST = (const bf16_t*)(p.ws + OFF_ST); const bf16_t* VN = (const bf16_t*)(p.ws + OFF_UT);
  const float* GC = (const float*)(p.ws + OFF_GC);
  LAS float* osum = (LAS float*)lds;
  {
    const int dir = wid >> 2, ig = wid & 3, nproc = dir ? 63 - c : c;
    const size_t cidp = (((size_t)bl * 8 + h) * 2 + dir) * 64 + nproc, cidg = (((size_t)b * 8 + h) * 2 + dir) * 64 + nproc;
    const int i = 16 * ig + col; const size_t toki = t0 + (dir ? 63 - i : i);
    bf16x8 qb[2];
#pragma unroll
    for (int s = 0; s < 2; ++s) qb[s] = *(const bf16x8*)(QN + toki * 512 + h * 64 + 32 * s + 8 * q);
    const float gci = GC[cidg * 64 + i];
    f32x4 at[4];
#pragma unroll
    for (int m = 0; m < 4; ++m) {
      at[m] = (f32x4){0.f, 0.f, 0.f, 0.f};
      if (m <= ig) {
        const int jr = 16 * m + col; const size_t tokj = t0 + (dir ? 63 - jr : jr);
#pragma unroll
        for (int s = 0; s < 2; ++s) { const bf16x8 kf = *(const bf16x8*)(KN + tokj * 512 + h * 64 + 32 * s + 8 * q); at[m] = MFMA16(kf, qb[s], at[m]); }
        const f32x4 gcj = *(const f32x4*)(GC + cidg * 64 + 16 * m + 4 * q);
#pragma unroll
        for (int r = 0; r < 4; ++r) { const int j = 16 * m + 4 * q + r; at[m][r] = (i >= j) ? at[m][r] * __expf(gci - gcj[r]) : 0.f; }
      }
    }
    bf16x8 pb[2];
#pragma unroll
    for (int s = 0; s < 2; ++s) pb[s] = pack8(at[2 * s], at[2 * s + 1]);
    const float eg = __expf(gci);
    const int tokrow = dir ? 63 - i : i;
#pragma unroll
    for (int mv = 0; mv < 4; ++mv) {
      f32x4 acc = {0.f, 0.f, 0.f, 0.f};
#pragma unroll
      for (int s = 0; s < 2; ++s) { const bf16x8 sa = *(const bf16x8*)(ST + cidp * 4096 + (16 * mv + col) * 64 + 32 * s + 8 * q); acc = MFMA16(sa, qb[s], acc); }
      acc *= eg;
#pragma unroll
      for (int s = 0; s < 2; ++s) { const bf16_t* pv = VN + cidp * 4096 + (16 * mv + col) * 64 + 32 * s + 4 * q;
        acc = MFMA16(cat4(*(const bf16x4*)pv, *(const bf16x4*)(pv + 16)), pb[s], acc); }
      *(LAS f32x4*)(osum + (dir * 64 + tokrow) * 68 + 16 * mv + 4 * q) = acc;
    }
  }
  __syncthreads();
  {
    const int tok = tid >> 3, vg = tid & 7;
    const LAS float* o0 = osum + tok * 68 + vg * 8; const LAS float* o1 = o0 + 64 * 68;
    float o[8]; float ss = 0.f;
#pragma unroll
    for (int e = 0; e < 8; ++e) { o[e] = o0[e] + o1[e]; ss += o[e] * o[e]; }
    ss += __shfl_xor(ss, 1); ss += __shfl_xor(ss, 2); ss += __shfl_xor(ss, 4);
    const float r = rsqrtf(ss * (1.0f / 64.0f) + EPS);
    const u32x4 zv = *(const u32x4*)((const bf16_t*)(p.ws + OFF_Z) + (t0 + tok) * 512 + h * 64 + vg * 8);
    const float* nw = p.dn_norm_w + l * 64 + vg * 8;
    float res[8];
#pragma unroll
    for (int e = 0; e < 4; ++e) { const float zl = __uint_as_float(zv[e] << 16), zh = __uint_as_float(zv[e] & 0xffff0000u);
      res[2 * e] = o[2 * e] * r * nw[2 * e] * (zl * __builtin_amdgcn_rcpf(1.0f + __expf(-zl))); res[2 * e + 1] = o[2 * e + 1] * r * nw[2 * e + 1] * (zh * __builtin_amdgcn_rcpf(1.0f + __expf(-zh))); }
    u32x4 ov = {pk2(res[0], res[1]), pk2(res[2], res[3]), pk2(res[4], res[5]), pk2(res[6], res[7])};
    *(u32x4*)((bf16_t*)(p.ws + OFF_OA) + (t0 + tok) * 512 + h * 64 + vg * 8) = ov;
  }
  __syncthreads();
}

DI void dn_out_wave(const int tid, const Params& p, const int l, const int pass, const int item) {
  const int lane = tid & 63, col = lane & 15, q = lane >> 4;
  const int h = item & 7, c = (item >> 3) & 63, bl = item >> 9, b = pass * 4 + bl;
  const size_t t0 = (size_t)b * SEQ + c * 64;
  const bf16_t* QN = (const bf16_t*)(p.ws + OFF_QN); const bf16_t* KN = (const bf16_t*)(p.ws + OFF_KN);
  const bf16_t* ST = (const bf16_t*)(p.ws + OFF_ST); const bf16_t* VN = (const bf16_t*)(p.ws + OFF_UT);
  const float* GC = (const float*)(p.ws + OFF_GC);
  const bf16_t* Zb = (const bf16_t*)(p.ws + OFF_Z); bf16_t* OA = (bf16_t*)(p.ws + OFF_OA);
#pragma unroll 1
  for (int ig = 0; ig < 4; ++ig) {
    const int tl = 16 * ig + col; const size_t tokq = t0 + tl;
    bf16x8 qb[2];
#pragma unroll
    for (int s = 0; s < 2; ++s) qb[s] = *(const bf16x8*)(QN + tokq * 512 + h * 64 + 32 * s + 8 * q);
    f32x4 o[4];
#pragma unroll
    for (int mv = 0; mv < 4; ++mv) o[mv] = (f32x4){0.f, 0.f, 0.f, 0.f};
#pragma unroll
    for (int dir = 0; dir < 2; ++dir) {
      const int nproc = dir ? 63 - c : c, i = dir ? 63 - tl : tl, igd = dir ? 3 - ig : ig;
      const size_t cidp = (((size_t)bl * 8 + h) * 2 + dir) * 64 + nproc, cidg = (((size_t)b * 8 + h) * 2 + dir) * 64 + nproc;
      const float gci = GC[cidg * 64 + i];
      f32x4 at[4];
#pragma unroll
      for (int m = 0; m < 4; ++m) {
        at[m] = (f32x4){0.f, 0.f, 0.f, 0.f};
        if (m <= igd) {
          const int jr = 16 * m + col; const size_t tokj = t0 + (dir ? 63 - jr : jr);
#pragma unroll
          for (int s = 0; s < 2; ++s) { const bf16x8 kf = *(const bf16x8*)(KN + tokj * 512 + h * 64 + 32 * s + 8 * q); at[m] = MFMA16(kf, qb[s], at[m]); }
          const f32x4 gcj = *(const f32x4*)(GC + cidg * 64 + 16 * m + 4 * q);
#pragma unroll
          for (int r = 0; r < 4; ++r) { const int j = 16 * m + 4 * q + r; at[m][r] = (i >= j) ? at[m][r] * __expf(gci - gcj[r]) : 0.f; }
        }
      }
      bf16x8 pb[2];
#pragma unroll
      for (int s = 0; s < 2; ++s) pb[s] = pack8(at[2 * s], at[2 * s + 1]);
      const float eg = __expf(gci);
#pragma unroll
      for (int mv = 0; mv < 4; ++mv) {
        f32x4 acc = {0.f, 0.f, 0.f, 0.f};
#pragma unroll
        for (int s = 0; s < 2; ++s) { const bf16x8 sa = *(const bf16x8*)(ST + cidp * 4096 + (16 * mv + col) * 64 + 32 * s + 8 * q); acc = MFMA16(sa, qb[s], acc); }
        acc *= eg;
#pragma unroll
        for (int s = 0; s < 2; ++s) { const bf16_t* pv = VN + cidp * 4096 + (16 * mv + col) * 64 + 32 * s + 4 * q;
          acc = MFMA16(cat4(*(const bf16x4*)pv, *(const bf16x4*)(pv + 16)), pb[s], acc); }
        o[mv] += acc;
      }
    }
    float ss = 0.f;
#pragma unroll
    for (int mv = 0; mv < 4; ++mv) ss += o[mv][0] * o[mv][0] + o[mv][1] * o[mv][1] + o[mv][2] * o[mv][2] + o[mv][3] * o[mv][3];
    ss += __shfl_xor(ss, 16); ss += __shfl_xor(ss, 32);
    const float rn = rsqrtf(ss * (1.0f / 64.0f) + EPS);
#pragma unroll
    for (int mv = 0; mv < 4; ++mv) {
      const int v0 = 16 * mv + 4 * q;
      const u32x2 zv = *(const u32x2*)(Zb + tokq * 512 + h * 64 + v0);
      const f32x4 nw = *(const f32x4*)(p.dn_norm_w + l * 64 + v0);
      const float z0 = __uint_as_float(zv[0] << 16), z1 = __uint_as_float(zv[0] & 0xffff0000u), z2 = __uint_as_float(zv[1] << 16), z3 = __uint_as_float(zv[1] & 0xffff0000u);
      const float r0 = o[mv][0] * rn * nw[0] * (z0 * __builtin_amdgcn_rcpf(1.0f + __expf(-z0))), r1 = o[mv][1] * rn * nw[1] * (z1 * __builtin_amdgcn_rcpf(1.0f + __expf(-z1)));
      const float r2 = o[mv][2] * rn * nw[2] * (z2 * __builtin_amdgcn_rcpf(1.0f + __expf(-z2))), r3 = o[mv][3] * rn * nw[3] * (z3 * __builtin_amdgcn_rcpf(1.0f + __expf(-z3)));
      u32x2 ov = {pk2(r0, r1), pk2(r2, r3)};
      *(u32x2*)(OA + tokq * 512 + h * 64 + v0) = ov;
    }
  }
}

constexpr unsigned OS_BUF = 65024, OS_SS = 2 * OS_BUF;
DI void dn_out_phase(const int tid, const Params& p, const int l, const int pass, LAS uchar* lds) {
  const int lane = tid & 63, wid = __builtin_amdgcn_readfirstlane(tid >> 6), col = lane & 15, q = lane >> 4, ig = wid & 3, vh = wid >> 2;
  const bf16_t* QN = (const bf16_t*)(p.ws + OFF_QN); const bf16_t* KN = (const bf16_t*)(p.ws + OFF_KN);
  const bf16_t* ST = (const bf16_t*)(p.ws + OFF_ST); const bf16_t* VN = (const bf16_t*)(p.ws + OFF_UT);
  const float* GC = (const float*)(p.ws + OFF_GC);
  const bf16_t* Zb = (const bf16_t*)(p.ws + OFF_Z); bf16_t* OA = (bf16_t*)(p.ws + OFF_OA);
  const int G = gridDim.x, row = tid >> 3, c8 = tid & 7;
  const unsigned ldst = row * 144 + c8 * 16;
  u32x4 stg[7]; u32x4 gst = {0u, 0u, 0u, 0u};
#define OUT_ISSUE(item) do { const int h_ = (item) & 7, c_ = ((item) >> 3) & 63, bl_ = (item) >> 9, b_ = pass * 4 + bl_; \
    const size_t t0_ = (size_t)b_ * SEQ + c_ * 64, gf_ = (((size_t)bl_ * 8 + h_) * 2) * 64 + c_, gb_ = (((size_t)bl_ * 8 + h_) * 2 + 1) * 64 + (63 - c_); \
    stg[0] = *(const u32x4*)(QN + (t0_ + row) * 512 + h_ * 64 + c8 * 8); stg[1] = *(const u32x4*)(KN + (t0_ + row) * 512 + h_ * 64 + c8 * 8); \
    stg[2] = *(const u32x4*)(ST + gf_ * 4096 + row * 64 + c8 * 8); stg[3] = *(const u32x4*)(ST + gb_ * 4096 + row * 64 + c8 * 8); \
    stg[4] = *(const u32x4*)(VN + gf_ * 4096 + row * 64 + c8 * 8); stg[5] = *(const u32x4*)(VN + gb_ * 4096 + row * 64 + c8 * 8); \
    stg[6] = *(const u32x4*)(Zb + (t0_ + row) * 512 + h_ * 64 + c8 * 8); \
    if (tid < 32) { const size_t gg_ = (tid < 16) ? ((((size_t)b_ * 8 + h_) * 2) * 64 + c_) : ((((size_t)b_ * 8 + h_) * 2 + 1) * 64 + (63 - c_)); gst = *(const u32x4*)(GC + gg_ * 64 + (tid & 15) * 4); } } while (0)
#define OUT_STORE(buf) do { LAS uchar* b__ = lds + (buf) * OS_BUF; _Pragma("unroll") for (int a = 0; a < 7; ++a) *(LAS u32x4*)(b__ + a * 9216 + ldst) = stg[a]; \
    if (tid < 32) *(LAS u32x4*)(b__ + 64512 + tid * 16) = gst; } while (0)
  int item = blockIdx.x, cur = 0;
  if (item < 2048) { OUT_ISSUE(item); OUT_STORE(0); }
  __syncthreads();
  for (; item < 2048; item += G, cur ^= 1) {
    const int nxt = item + G;
    if (nxt < 2048) OUT_ISSUE(nxt);
    const int h = item & 7, c = (item >> 3) & 63, bl = item >> 9, b = pass * 4 + bl;
    const size_t t0 = (size_t)b * SEQ + c * 64;
    const LAS uchar* B = lds + cur * OS_BUF;
    const int tl = 16 * ig + col;
    bf16x8 qb[2];
#pragma unroll
    for (int s = 0; s < 2; ++s) qb[s] = *(const LAS bf16x8*)(B + tl * 144 + 64 * s + 16 * q);
    f32x4 o[2];
    o[0] = (f32x4){0.f, 0.f, 0.f, 0.f}; o[1] = o[0];
#pragma unroll
    for (int dir = 0; dir < 2; ++dir) {
      const int i = dir ? 63 - tl : tl, igd = dir ? 3 - ig : ig;
      const LAS float* gcd = (const LAS float*)(B + 64512) + dir * 64;
      const float gci = gcd[i];
      f32x4 at[4];
#pragma unroll
      for (int m = 0; m < 4; ++m) {
        at[m] = (f32x4){0.f, 0.f, 0.f, 0.f};
        if (m <= igd) {
          const int jr = 16 * m + col, trow = dir ? 63 - jr : jr;
#pragma unroll
          for (int s = 0; s < 2; ++s) { const bf16x8 kf = *(const LAS bf16x8*)(B + 9216 + trow * 144 + 64 * s + 16 * q); at[m] = MFMA16(kf, qb[s], at[m]); }
          const f32x4 gcj = *(const LAS f32x4*)(gcd + 16 * m + 4 * q);
#pragma unroll
          for (int r = 0; r < 4; ++r) { const int j = 16 * m + 4 * q + r; at[m][r] = (i >= j) ? at[m][r] * __expf(gci - gcj[r]) : 0.f; }
        }
      }
      bf16x8 pb[2];
#pragma unroll
      for (int s = 0; s < 2; ++s) pb[s] = pack8(at[2 * s], at[2 * s + 1]);
      const float eg = __expf(gci);
      const LAS uchar* Sd = B + (2 + dir) * 9216; const LAS uchar* Vd = B + (4 + dir) * 9216;
#pragma unroll
      for (int mvi = 0; mvi < 2; ++mvi) {
        const int vr = 16 * (2 * vh + mvi) + col;
        f32x4 acc = {0.f, 0.f, 0.f, 0.f};
#pragma unroll
        for (int s = 0; s < 2; ++s) { const bf16x8 sa = *(const LAS bf16x8*)(Sd + vr * 144 + 64 * s + 16 * q); acc = MFMA16(sa, qb[s], acc); }
        acc *= eg;
#pragma unroll
        for (int s = 0; s < 2; ++s) { const LAS uchar* pv = Vd + vr * 144 + 64 * s + 8 * q;
          acc = MFMA16(cat4(*(const LAS bf16x4*)pv, *(const LAS bf16x4*)(pv + 32)), pb[s], acc); }
        o[mvi] += acc;
      }
    }
    float ss = 0.f;
#pragma unroll
    for (int mvi = 0; mvi < 2; ++mvi) ss += o[mvi][0] * o[mvi][0] + o[mvi][1] * o[mvi][1] + o[mvi][2] * o[mvi][2] + o[mvi][3] * o[mvi][3];
    ss += __shfl_xor(ss, 16); ss += __shfl_xor(ss, 32);
    LAS float* ssum = (LAS float*)(lds + OS_SS);
    if (q == 0) ssum[vh * 64 + tl] = ss;
    __syncthreads();
    const float rn = rsqrtf((ssum[tl] + ssum[64 + tl]) * (1.0f / 64.0f) + EPS);
#pragma unroll
    for (int mvi = 0; mvi < 2; ++mvi) {
      const int v0 = 16 * (2 * vh + mvi) + 4 * q;
      const u32x2 zv = *(const LAS u32x2*)(B + 6 * 9216 + tl * 144 + v0 * 2);
      const f32x4 nw = *(const f32x4*)(p.dn_norm_w + l * 64 + v0);
      const float z0 = __uint_as_float(zv[0] << 16), z1 = __uint_as_float(zv[0] & 0xffff0000u), z2 = __uint_as_float(zv[1] << 16), z3 = __uint_as_float(zv[1] & 0xffff0000u);
      const float r0 = o[mvi][0] * rn * nw[0] * (z0 * __builtin_amdgcn_rcpf(1.0f + __expf(-z0))), r1 = o[mvi][1] * rn * nw[1] * (z1 * __builtin_amdgcn_rcpf(1.0f + __expf(-z1)));
      const float r2 = o[mvi][2] * rn * nw[2] * (z2 * __builtin_amdgcn_rcpf(1.0f + __expf(-z2))), r3 = o[mvi][3] * rn * nw[3] * (z3 * __builtin_amdgcn_rcpf(1.0f + __expf(-z3)));
      u32x2 ov = {pk2(r0, r1), pk2(r2, r3)};
      *(u32x2*)(OA + (t0 + tl) * 512 + h * 64 + v0) = ov;
    }
    if (nxt < 2048) OUT_STORE(cur ^ 1);
    __syncthreads();
  }
#undef OUT_ISSUE
#undef OUT_STORE
}

DI void attn_item(const int tid, const Params& p, const int l, const int item, LAS uchar* lds) {
  const int lane = tid & 63, wid = tid >> 6, col = lane & 31, hh = lane >> 5;
  const int qblk = item & 31, kvh = (item >> 5) & 1, b = item >> 6;
  const int t0 = qblk * 128; const size_t rowbase = (size_t)b * SEQ;
  const bf16_t* Cb = (const bf16_t*)(p.ws + OFF_C);
  bf16_t* OB = (bf16_t*)(p.ws + OFF_OB);
  LAS bf16_t* Ks = (LAS bf16_t*)lds; LAS bf16_t* VT = (LAS bf16_t*)(lds + 384 * 72 * 2);
#pragma unroll 1
  for (int it = 0; it < 6; ++it) {
    const int idx = it * 512 + tid, r = idx >> 3, pc = idx & 7, s = t0 - 128 + r;
    u32x4 kv = {0u, 0u, 0u, 0u}, vv = {0u, 0u, 0u, 0u};
    if (s >= 0 && s < SEQ) { const bf16_t* src = Cb + (rowbase + s) * 768 + 512 + kvh * 64 + pc * 8; kv = *(const u32x4*)src; vv = *(const u32x4*)(src + 128); }
    *(LAS u32x4*)(Ks + r * 72 + pc * 8) = kv;
#pragma unroll
    for (int e = 0; e < 4; ++e) { VT[(pc * 8 + 2 * e) * 392 + r] = (bf16_t)(vv[e] & 0xffffu); VT[(pc * 8 + 2 * e + 1) * 392 + r] = (bf16_t)(vv[e] >> 16); }
  }
  __syncthreads();
  {
    const int g = wid >> 1, qh = wid & 1, hq = kvh * 4 + g;
    const float slope = exp2f(-(float)(hq + 1)), sink = p.attn_sink[l * 8 + hq];
#pragma unroll 1
    for (int qg = 0; qg < 2; ++qg) {
      const int q0 = 64 * qh + 32 * qg; const size_t tokq = rowbase + t0 + q0 + col;
      bf16x8 qf[4];
#pragma unroll
      for (int s = 0; s < 4; ++s) qf[s] = *(const bf16x8*)(Cb + tokq * 768 + hq * 64 + 16 * s + 8 * hh);
      float m_run = sink, l_run = 1.0f;
      f32x16 o0, o1;
#pragma unroll
      for (int r = 0; r < 16; ++r) { o0[r] = 0.f; o1[r] = 0.f; }
      const int kt0 = q0 >> 5;
#pragma unroll 1
      for (int kt = kt0; kt < kt0 + 9; ++kt) {
        f32x16 sc;
#pragma unroll
        for (int r = 0; r < 16; ++r) sc[r] = 0.f;
#pragma unroll
        for (int s = 0; s < 4; ++s) { const bf16x8 kf = *(const LAS bf16x8*)(Ks + (32 * kt + col) * 72 + 16 * s + 8 * hh); sc = MFMA32(kf, qf[s], sc); }
        float tmax = -INFINITY;
#pragma unroll
        for (int r = 0; r < 16; ++r) {
          const int kl = 32 * kt + (r & 3) + 8 * (r >> 2) + 4 * hh, sg = t0 - 128 + kl, d = q0 + col + 128 - kl, ad = d < 0 ? -d : d;
          const bool valid = (ad <= 128) && (sg >= 0) && (sg < SEQ);
          sc[r] = valid ? sc[r] * 0.125f - slope * (float)ad : -INFINITY;
          tmax = fmaxf(tmax, sc[r]);
        }
        tmax = fmaxf(tmax, __shfl_xor(tmax, 32));
        const float mn = fmaxf(m_run, tmax), alpha = __expf(m_run - mn);
        float psum = 0.f;
#pragma unroll
        for (int r = 0; r < 16; ++r) { sc[r] = __expf(sc[r] - mn); psum += sc[r]; }
        psum += __shfl_xor(psum, 32);
        l_run = l_run * alpha + psum; m_run = mn;
#pragma unroll
        for (int r = 0; r < 16; ++r) { o0[r] *= alpha; o1[r] *= alpha; }
        bf16x8 pf[2];
#pragma unroll
        for (int s = 0; s < 2; ++s) { u32x4 w = {pk2(sc[8 * s], sc[8 * s + 1]), pk2(sc[8 * s + 2], sc[8 * s + 3]), pk2(sc[8 * s + 4], sc[8 * s + 5]), pk2(sc[8 * s + 6], sc[8 * s + 7])}; pf[s] = __builtin_bit_cast(bf16x8, w); }
#pragma unroll
        for (int s = 0; s < 2; ++s) {
          const LAS bf16_t* v0 = VT + col * 392 + 32 * kt + 16 * s + 4 * hh; const LAS bf16_t* v1 = v0 + 32 * 392;
          o0 = MFMA32(cat4(*(const LAS bf16x4*)v0, *(const LAS bf16x4*)(v0 + 8)), pf[s], o0);
          o1 = MFMA32(cat4(*(const LAS bf16x4*)v1, *(const LAS bf16x4*)(v1 + 8)), pf[s], o1);
        }
      }
      const float inv = 1.0f / l_run;
      bf16_t* dst = OB + tokq * 512 + hq * 64 + 4 * hh;
#pragma unroll
      for (int rg = 0; rg < 4; ++rg) {
        u32x2 a = {pk2(o0[4 * rg] * inv, o0[4 * rg + 1] * inv), pk2(o0[4 * rg + 2] * inv, o0[4 * rg + 3] * inv)};
        u32x2 c2 = {pk2(o1[4 * rg] * inv, o1[4 * rg + 1] * inv), pk2(o1[4 * rg + 2] * inv, o1[4 * rg + 3] * inv)};
        *(u32x2*)(dst + 8 * rg) = a; *(u32x2*)(dst + 32 + 8 * rg) = c2;
      }
    }
  }
  __syncthreads();
}


#define XB_TMO      128
#define XB_XCNT(j)  (256  + 64 * (j))
#define XB_XSUB(j)  (1280 + 64 * (j))
#define XB_XGEN(j)  (2304 + 64 * (j))
#define XB_TOP      3328
#define XB_TOPGEN   3392
#define XCD_BAR_WORDS 3456
#define XB_SPIN_CAP (1u << 18)
DI unsigned xb_ld(unsigned* p)              { return __hip_atomic_load(p, __ATOMIC_RELAXED, __HIP_MEMORY_SCOPE_AGENT); }
DI unsigned xb_add(unsigned* p, unsigned v) { return __hip_atomic_fetch_add(p, v, __ATOMIC_RELAXED, __HIP_MEMORY_SCOPE_AGENT); }
DI unsigned xb_xcc_id() { return (unsigned)__builtin_amdgcn_s_getreg((3 << 11) | 20) & 0xFu; }
#define XB_SPIN(cond, bar) do { unsigned _sp = 0; while (cond) { __builtin_amdgcn_s_sleep(1); \
    if ((++_sp & 255u) == 0u) { if (xb_ld(&(bar)[XB_TMO])) break; if (_sp > XB_SPIN_CAP) { atomicAdd(&(bar)[XB_TMO], 1u); break; } } } } while (0)
struct XcdBarrier { unsigned* bar; unsigned x; volatile LAS unsigned* st; };
DI XcdBarrier xcd_barrier_post(unsigned* bar, volatile LAS unsigned* st) {
  XcdBarrier b; b.bar = bar; b.x = xb_xcc_id(); b.st = st;
  if (threadIdx.x == 0) (void)xb_add(&bar[XB_XCNT(b.x)], 1u);
  return b;
}
DI void xcd_barrier_complete(unsigned* bar, unsigned x, unsigned& nloc, unsigned& nx) {
  const unsigned G = gridDim.x * gridDim.y * gridDim.z;
  unsigned sum, cnt, mine, sp = 0u;
  for (;;) {
    sum = 0u; cnt = 0u; mine = 0u;
#pragma unroll
    for (unsigned j = 0; j < 16; ++j) { const unsigned c = xb_ld(&bar[XB_XCNT(j)]); sum += c; cnt += (c > 0u) ? 1u : 0u; mine = (j == x) ? c : mine; }
    if (sum == G) break;
    __builtin_amdgcn_s_sleep(1);
    if ((++sp & 255u) == 0u) { if (xb_ld(&bar[XB_TMO])) break; if (sp > XB_SPIN_CAP) { atomicAdd(&bar[XB_TMO], 1u); break; } }
  }
  nloc = mine > 0u ? mine : 1u; nx = cnt > 0u ? cnt : 1u;
}
DI void xcd_barrier(const XcdBarrier& b) {
  asm volatile("s_waitcnt vmcnt(0)" ::: "memory");
  __syncthreads();
  if (threadIdx.x == 0) {
    unsigned* bar = b.bar;
    __builtin_amdgcn_s_waitcnt(0);
    unsigned nloc = b.st[0], nx = b.st[1];
    if (nloc == 0u) { xcd_barrier_complete(bar, b.x, nloc, nx); b.st[0] = nloc; b.st[1] = nx; }
    const unsigned old = xb_add(&bar[XB_XSUB(b.x)], 1u);
    const unsigned gen = old / nloc;
    if (old + 1u == (gen + 1u) * nloc) {
      __builtin_amdgcn_fence(__ATOMIC_RELEASE, "agent");
      asm volatile("s_waitcnt vmcnt(0)" ::: "memory");
      const unsigned og = xb_add(&bar[XB_TOP], 1u);
      const unsigned tg = og / nx;
      if (og + 1u == (tg + 1u) * nx) xb_add(&bar[XB_TOPGEN], 1u);
      else XB_SPIN(xb_ld(&bar[XB_TOPGEN]) == tg, bar);
      __builtin_amdgcn_fence(__ATOMIC_ACQUIRE, "agent");
      xb_add(&bar[XB_XGEN(b.x)], 1u);
      asm volatile("s_waitcnt vmcnt(0)" ::: "memory");
    } else {
      XB_SPIN(xb_ld(&bar[XB_XGEN(b.x)]) == gen, bar);
      __builtin_amdgcn_fence(__ATOMIC_ACQUIRE, "agent");
      asm volatile("s_waitcnt vmcnt(0)" ::: "memory");
    }
  }
  __syncthreads();
}

constexpr int PH_PER_LAYER = 14, N_PHASES = 1 + 2 * PH_PER_LAYER;

DI void run_phase(const Params& pin, const int ph, LAS uchar* lds) {
  const int G = gridDim.x, c = blockIdx.x;
  int tid = threadIdx.x; asm volatile("" : "+v"(tid));
  Params p = pin; { size_t off = 0; asm volatile("" : "+s"(off)); p.ws = pin.ws + off; }
  if (ph == 0) {
    rownorm_phase(tid, p.x, nullptr, nullptr, nullptr, nullptr, nullptr, p.n_mix_pre, (bf16_t*)(p.ws + OFF_H));
    wconv_phase(tid, p, lds, 0, 2560, c, G);
    return;
  }
  const int l = (ph - 1) / PH_PER_LAYER, k = (ph - 1) % PH_PER_LAYER;
  uchar* wl = p.ws + OFF_W + (size_t)l * W_LAYER;
  switch (k) {
    case 0: {
      pg8::SchedStd S; S.init(p.ws + OFF_H, wl + WO_IN, MTOK, 3072, 1024, G, c);
      pg8::EpiG1a E{(bf16_t*)(p.ws + OFF_A), (bf16_t*)(p.ws + OFF_Z), (bf16_t*)(p.ws + OFF_C), (float*)(p.ws + OFF_E)};
      pg8::gemm_phase(tid, lds, 1024, S, E);
    } break;
    case 1: case 4: { const int pass = k == 1 ? 0 : 1; for (int it = c; it < 1024; it += G) dn_prep_item(tid, p, l, pass, it, lds); } break;
    case 2: case 5: { const int pass = k == 2 ? 0 : 1;
      if (c < 64) dn_scan_block(tid, p, pass, c, lds);
      else { for (int it = c - 64; it < 256; it += G - 64) attn_item(tid, p, l, pass * 256 + it, lds);
        if (l == 0) { if (pass == 0) wconv_phase(tid, p, lds, 2560, 7680, c - 64, G - 64); else wconv_phase(tid, p, lds, 7680, 15360, c - 64, G - 64); } }
    } break;
    case 3: case 6: { const int pass = k == 3 ? 0 : 1; dn_out_phase(tid, p, l, pass, lds); } break;
    case 7: {
      pg8::SchedStd S; S.init(p.ws + OFF_H, wl + WO_IN + (size_t)3072 * 1024 * 2, MTOK, 2048, 1024, G, c);
      pg8::EpiBf16<0> E{(bf16_t*)(p.ws + OFF_D), 2048};
      pg8::gemm_phase(tid, lds, 1024, S, E);
    } break;
    case 8: {
      pg8::SchedG2 S{(const char*)(p.ws + OFF_OA), (long)OFF_OB - (long)OFF_OA, (const char*)(wl + WO_UP), G, c};
      pg8::EpiG2 E{(const bf16_t*)(p.ws + OFF_D), (bf16_t*)(p.ws + OFF_T), (bf16_t*)(p.ws + OFF_H)};
      pg8::gemm_phase(tid, lds, 512, S, E);
    } break;
    case 9: {
      pg8::SchedStd S; S.init(p.ws + OFF_H, wl + WO_OUT, MTOK, 1024, 1024, G, c);
      pg8::EpiBf16<0> E{(bf16_t*)(p.ws + OFF_MIX), 1024};
      pg8::gemm_phase(tid, lds, 1024, S, E);
    } break;
    case 10: rownorm_phase(tid, l == 0 ? p.x : p.out, nullptr, (const bf16_t*)(p.ws + OFF_MIX), p.n_mix_post + l * DM, nullptr, (bf16_t*)(p.ws + OFF_XB), p.n_mlp_pre + l * DM, (bf16_t*)(p.ws + OFF_H)); break;
    case 11: {
      pg8::SchedStd S; S.init(p.ws + OFF_H, wl + WO_W1, MTOK, 4096, 1024, G, c);
      pg8::EpiBf16<1> E{(bf16_t*)(p.ws + OFF_U), 4096};
      pg8::gemm_phase(tid, lds, 1024, S, E);
    } break;
    case 12: {
      pg8::SchedStd S; S.init(p.ws + OFF_U, wl + WO_W2, MTOK, 1024, 4096, G, c);
      pg8::EpiBf16<0> E{(bf16_t*)(p.ws + OFF_Y), 1024};
      pg8::gemm_phase(tid, lds, 4096, S, E);
    } break;
    case 13: rownorm_phase(tid, nullptr, (const bf16_t*)(p.ws + OFF_XB), (const bf16_t*)(p.ws + OFF_Y), p.n_mlp_post + l * DM, p.out, nullptr, l == 0 ? p.n_mix_pre + DM : nullptr, (bf16_t*)(p.ws + OFF_H)); break;
  }
}

__global__ void __launch_bounds__(512) mega(Params p, int ph_lo, int ph_hi) {
  extern __shared__ __attribute__((aligned(16))) uchar lds_raw[];
  LAS uchar* lds = (LAS uchar*)lds_raw;
  cg::grid_group grid = cg::this_grid();
  unsigned* bar = (unsigned*)(p.ws + OFF_BAR);
  volatile LAS unsigned* st = (volatile LAS unsigned*)(lds + LDS_ST_OFF);
  if (threadIdx.x < 2) st[threadIdx.x] = 0u;
  if (blockIdx.x == 0) for (int i = threadIdx.x; i < XCD_BAR_WORDS; i += 512) bar[i] = 0u;
  __syncthreads();
  XcdBarrier xb; xb.bar = bar; xb.x = 0; xb.st = st;
  for (int ph = ph_lo; ph <= ph_hi; ++ph) {
    int reps = 1;
#ifdef DUP_MASK
    if (ph > 0 && ((DUP_MASK >> ((ph - 1) % PH_PER_LAYER)) & 1)) reps = 2;
#endif
    for (int r = 0; r < reps; ++r) { if (r) __syncthreads(); run_phase(p, ph, lds); }
    if (ph < ph_hi) { if (ph == ph_lo) { grid.sync(); xb = xcd_barrier_post(bar, st); } else xcd_barrier(xb); }
  }
}

extern "C" void kernel_launch(void* const* d_in, const int* in_sizes, int n_in, void* d_out, int out_size, void* d_ws, size_t ws_size, hipStream_t stream) {
  static int grid_blocks = 0;
  if (!grid_blocks) {
    int dev = 0, cus = 0, per_cu = 0;
    (void)hipGetDevice(&dev);
    (void)hipDeviceGetAttribute(&cus, hipDeviceAttributeMultiprocessorCount, dev);
    (void)hipFuncSetAttribute((const void*)mega, hipFuncAttributeMaxDynamicSharedMemorySize, (int)kDynLds);
    (void)hipOccupancyMaxActiveBlocksPerMultiprocessor(&per_cu, mega, 512, kDynLds);
    if (per_cu < 1) fprintf(stderr, "occupancy query returned %d\n", per_cu);
    grid_blocks = cus;
    if (ws_size < WS_NEEDED) fprintf(stderr, "workspace too small: %zu\n", ws_size);
  }
  Params p{};
  p.x = (const float*)d_in[0]; p.w_in = (const float*)d_in[1]; p.conv_w = (const float*)d_in[2]; p.a_log = (const float*)d_in[3]; p.dt_bias = (const float*)d_in[4];
  p.dn_norm_w = (const float*)d_in[5]; p.attn_sink = (const float*)d_in[6]; p.w_up_a = (const float*)d_in[7]; p.w_up_b = (const float*)d_in[8]; p.w_out = (const float*)d_in[9];
  p.n_mix_pre = (const float*)d_in[10]; p.n_mix_post = (const float*)d_in[11]; p.n_mlp_pre = (const float*)d_in[12]; p.n_mlp_post = (const float*)d_in[13];
  p.w_mlp_in = (const float*)d_in[14]; p.w_mlp_out = (const float*)d_in[15];
  p.out = (float*)d_out; p.ws = (uchar*)d_ws;
  int lo = 0, hi = N_PHASES - 1;
  void* args[] = {&p, &lo, &hi};
  hipError_t e = hipLaunchCooperativeKernel((void*)mega, dim3(grid_blocks), dim3(512), args, kDynLds, stream);
  if (e != hipSuccess) fprintf(stderr, "cooperative launch failed: %s (grid %d)\n", hipGetErrorString(e), grid_blocks);
}
```
